# Optimizing an MI355X kernel written in HIP

```python
import math
import jax, jax.numpy as jnp
from jax import lax
import numpy as np

D_MODEL = 2048
BATCH = 2
SEQ = 4096
DEPTH = 1
DEC_BATCH = 128
DEC_SEQ = 8
PAST_LEN = 8192
PAGE_SIZE = 128

HEAD_DIM = 64
N_Q_HEADS = 16
N_KV_HEADS = 4
GQA = N_Q_HEADS // N_KV_HEADS
ATTN_WIDTH = N_Q_HEADS * HEAD_DIM
KV_WIDTH = N_KV_HEADS * HEAD_DIM
WINDOW = 128
ATTN_BLOCK = 128
ROPE_THETA = 10000.0
LRU_WIDTH = D_MODEL - ATTN_WIDTH
LRU_BLOCKS = 16
LRU_BLOCK = LRU_WIDTH // LRU_BLOCKS
CONV_W = 4
LRU_C = 8.0
IN_WIDTH = ATTN_WIDTH + 2 * KV_WIDTH + 2 * LRU_WIDTH
N_KEYS = 128
N_EXPERTS = N_KEYS * N_KEYS
PEER_HEADS = 8
PEER_TOPK = 16
D_KEY = 256
PEER_CHUNK = 128
EPS = 1e-6
NEG_INF = -1e30

kernel_name = "hymba_swa_sink_rglru_peer_step"


def _rmsnorm(x, g):
    xf = x.astype(jnp.float32)
    y = xf * lax.rsqrt(jnp.mean(xf * xf, axis=-1, keepdims=True) + EPS)
    return (y * g.astype(jnp.float32)).astype(x.dtype)


def _rope(x, pos):
    half = HEAD_DIM // 2
    inv = jnp.exp(-math.log(ROPE_THETA) * jnp.arange(half, dtype=jnp.float32) * (2.0 / HEAD_DIM))
    ang = pos[:, None] * inv[None, :]
    cos = jnp.cos(ang)[:, None, :]
    sin = jnp.sin(ang)[:, None, :]
    xf = x.astype(jnp.float32)
    x1, x2 = xf[..., :half], xf[..., half:]
    return jnp.concatenate([x1 * cos - x2 * sin, x2 * cos + x1 * sin], axis=-1).astype(x.dtype)


def _split_in(z):
    cuts = np.cumsum([ATTN_WIDTH, KV_WIDTH, KV_WIDTH, LRU_WIDTH]).tolist()
    return jnp.split(z, cuts, axis=-1)


def _qk_prep(q, k, v, pos, g_q, g_k):
    b, t = q.shape[:2]
    q = _rope(_rmsnorm(q.reshape(b, t, N_Q_HEADS, HEAD_DIM), g_q), pos)
    k = _rope(_rmsnorm(k.reshape(b, t, N_KV_HEADS, HEAD_DIM), g_k), pos)
    return q, k, v.reshape(b, t, N_KV_HEADS, HEAD_DIM)


def _sink_softmax(logits, mask, sink):
    logits = jnp.where(mask, logits, NEG_INF)
    m = jnp.maximum(jnp.max(logits, axis=-1, keepdims=True), sink)
    e = jnp.exp(logits - m)
    return e / (jnp.sum(e, axis=-1, keepdims=True) + jnp.exp(sink - m))


def _attn_banded(q, k, v, sink):
    b, t = q.shape[:2]
    nb = t // ATTN_BLOCK
    qb = q.reshape(b, nb, ATTN_BLOCK, N_KV_HEADS, GQA, HEAD_DIM)
    kb = k.reshape(b, nb, ATTN_BLOCK, N_KV_HEADS, HEAD_DIM)
    vb = v.reshape(b, nb, ATTN_BLOCK, N_KV_HEADS, HEAD_DIM)
    shift = lambda a: jnp.concatenate([jnp.zeros_like(a[:, :1]), a[:, :-1]], axis=1)
    kc = jnp.concatenate([shift(kb), kb], axis=2)
    vc = jnp.concatenate([shift(vb), vb], axis=2)
    logits = jnp.einsum('bnqkgd,bnskd->bnkgqs', qb, kc).astype(jnp.float32) * (HEAD_DIM ** -0.5)
    i = jnp.arange(ATTN_BLOCK)[:, None]
    j = jnp.arange(2 * ATTN_BLOCK)[None, :]
    diff = i + ATTN_BLOCK - j
    band = (diff >= 0) & (diff < WINDOW)
    mask = band[None] & ((jnp.arange(nb)[:, None, None] > 0) | (j[None] >= ATTN_BLOCK))
    p = _sink_softmax(logits, mask[:, None, None], sink)
    o = jnp.einsum('bnkgqs,bnskd->bnqkgd', p.astype(v.dtype), vc)
    return o.reshape(b, t, ATTN_WIDTH)


def _attn_window_cache(q, k, v, ck, cv, sink):
    b, s = q.shape[:2]
    w = ck.shape[1]
    kall = jnp.concatenate([ck.astype(k.dtype), k], axis=1)
    vall = jnp.concatenate([cv.astype(v.dtype), v], axis=1)
    qpos = PAST_LEN + jnp.arange(s)
    kpos = PAST_LEN - w + jnp.arange(w + s)
    diff = qpos[:, None] - kpos[None, :]
    mask = (diff >= 0) & (diff < WINDOW)
    qg = q.reshape(b, s, N_KV_HEADS, GQA, HEAD_DIM)
    logits = jnp.einsum('bqkgd,bskd->bkgqs', qg, kall).astype(jnp.float32) * (HEAD_DIM ** -0.5)
    p = _sink_softmax(logits, mask, sink)
    o = jnp.einsum('bkgqs,bskd->bqkgd', p.astype(v.dtype), vall)
    return o.reshape(b, s, ATTN_WIDTH), kall[:, -w:], vall[:, -w:]


def _rg_lru(xr, yg, conv_prev, h0, conv_w, conv_b, w_a, b_a, w_x, b_x, lam):
    b, t, _ = xr.shape
    xp = jnp.concatenate([conv_prev.astype(xr.dtype), xr], axis=1)
    xc = sum(xp[:, j:j + t] * conv_w[j] for j in range(CONV_W)) + conv_b
    xb = xc.reshape(b, t, LRU_BLOCKS, LRU_BLOCK)
    r = jax.nn.sigmoid(jnp.einsum('btnd,nde->btne', xb, w_a) + b_a).reshape(b, t, LRU_WIDTH)
    ig = jax.nn.sigmoid(jnp.einsum('btnd,nde->btne', xb, w_x) + b_x).reshape(b, t, LRU_WIDTH)
    log_a = -LRU_C * r.astype(jnp.float32) * jax.nn.softplus(-lam.astype(jnp.float32))
    a = jnp.exp(log_a)
    u = jnp.sqrt(-jnp.expm1(2.0 * log_a)) * (ig * xc).astype(jnp.float32)
    u = u.at[:, 0].add(a[:, 0] * h0.astype(jnp.float32))
    comb = lambda l, rr: (l[0] * rr[0], rr[0] * l[1] + rr[1])
    _, h = lax.associative_scan(comb, (a, u), axis=1)
    y = h.astype(xr.dtype) * jax.nn.gelu(yg)
    return y, xp[:, -(CONV_W - 1):], h[:, -1].astype(xr.dtype)


def _peer(h, w_pq, sub_keys, peer_u, peer_v):
    n = h.shape[0]
    pad = (-n) % PEER_CHUNK
    hb = jnp.pad(h, ((0, pad), (0, 0))).reshape(-1, PEER_CHUNK, D_MODEL)

    def one(hc):
        c = hc.shape[0]
        q = (hc @ w_pq).reshape(c, PEER_HEADS, 2, D_KEY // 2)
        s = jnp.einsum('nhcd,hckd->nhck', q, sub_keys).astype(jnp.float32)
        sv, si = lax.top_k(s, PEER_TOPK)
        cand = (sv[:, :, 0, :, None] + sv[:, :, 1, None, :]).reshape(c, PEER_HEADS, -1)
        cid = (si[:, :, 0, :, None] * N_KEYS + si[:, :, 1, None, :]).reshape(c, PEER_HEADS, -1)
        best, pos = lax.top_k(cand, PEER_TOPK)
        eid = jnp.take_along_axis(cid, pos, axis=-1)
        g = jax.nn.softmax(best, axis=-1)
        act = jax.nn.gelu(jnp.einsum('nd,nhkd->nhk', hc, peer_u[eid]).astype(jnp.float32))
        return jnp.einsum('nhk,nhkd->nd', (g * act).astype(hc.dtype), peer_v[eid])

    return lax.map(one, hb).reshape(-1, D_MODEL)[:n]


def _layer(x, pos0, kv_cache, conv_prev, h0, lw):
    (g_mix, w_in, g_q, g_k, sinks, conv_w, conv_b, w_a, b_a, w_x, b_x, lam,
     g_ao, g_lo, w_out, g_ffn, w_pq, sub_keys, peer_u, peer_v) = lw
    b, t, _ = x.shape
    hn = _rmsnorm(x, g_mix)
    q, k, v, xr, yg = _split_in(hn @ w_in)
    pos = pos0 + jnp.arange(t, dtype=jnp.float32)
    q, k, v = _qk_prep(q, k, v, pos, g_q, g_k)
    sink = sinks.astype(jnp.float32).reshape(N_KV_HEADS, GQA, 1, 1)
    if kv_cache is None:
        ao = _attn_banded(q, k, v, sink)
        k_rows, v_rows = k[:, -WINDOW:], v[:, -WINDOW:]
    else:
        ao, k_rows, v_rows = _attn_window_cache(q, k, v, kv_cache[0], kv_cache[1], sink)
    lo, conv_new, h_new = _rg_lru(xr, yg, conv_prev, h0, conv_w, conv_b, w_a, b_a, w_x, b_x, lam)
    mixed = jnp.concatenate([_rmsnorm(ao, g_ao), _rmsnorm(lo, g_lo)], axis=-1) @ w_out
    x = x + mixed
    f = _peer(_rmsnorm(x, g_ffn).reshape(b * t, D_MODEL), w_pq, sub_keys, peer_u, peer_v)
    x = x + f.reshape(b, t, D_MODEL)
    return x, k_rows, v_rows, conv_new, h_new


def setup_inputs(seed: int = 0) -> dict:
    key = jax.random.key(seed)
    ks = jax.random.split(key, 32)
    nrm = lambda k, shape, s: jax.random.normal(k, shape, jnp.float32) * s
    gain = lambda k, shape: 1.0 + 0.02 * jax.random.normal(k, shape, jnp.float32)
    cache_len = min(WINDOW, PAST_LEN)
    u = jax.random.uniform(ks[12], (DEPTH, LRU_WIDTH), jnp.float32, 0.9, 0.999)
    a0 = u ** (1.0 / LRU_C)
    return {
        "x_prompt": nrm(ks[0], (BATCH, SEQ, D_MODEL), 1.0),
        "x_sample": nrm(ks[1], (DEC_BATCH, DEC_SEQ, D_MODEL), 1.0),
        "cache_k": nrm(ks[2], (DEPTH, DEC_BATCH, cache_len, N_KV_HEADS, HEAD_DIM), 1.0),
        "cache_v": nrm(ks[3], (DEPTH, DEC_BATCH, cache_len, N_KV_HEADS, HEAD_DIM), 1.0),
        "state_conv": nrm(ks[4], (DEPTH, DEC_BATCH, CONV_W - 1, LRU_WIDTH), 1.0),
        "state_h": nrm(ks[5], (DEPTH, DEC_BATCH, LRU_WIDTH), 0.5),
        "norm_mix_g": gain(ks[6], (DEPTH, D_MODEL)),
        "w_in": nrm(ks[7], (DEPTH, D_MODEL, IN_WIDTH), D_MODEL ** -0.5),
        "q_norm_g": gain(ks[8], (DEPTH, HEAD_DIM)),
        "k_norm_g": gain(ks[9], (DEPTH, HEAD_DIM)),
        "attn_sinks": nrm(ks[10], (DEPTH, N_Q_HEADS), 1.0),
        "conv_w": nrm(ks[11], (DEPTH, CONV_W, LRU_WIDTH), CONV_W ** -0.5),
        "conv_b": nrm(ks[13], (DEPTH, LRU_WIDTH), 0.01),
        "w_rec_gate": nrm(ks[14], (DEPTH, LRU_BLOCKS, LRU_BLOCK, LRU_BLOCK), LRU_BLOCK ** -0.5),
        "b_rec_gate": nrm(ks[15], (DEPTH, LRU_BLOCKS, LRU_BLOCK), 0.01),
        "w_in_gate": nrm(ks[16], (DEPTH, LRU_BLOCKS, LRU_BLOCK, LRU_BLOCK), LRU_BLOCK ** -0.5),
        "b_in_gate": nrm(ks[17], (DEPTH, LRU_BLOCKS, LRU_BLOCK), 0.01),
        "lru_lambda": jnp.log(a0) - jnp.log1p(-a0),
        "attn_out_g": gain(ks[18], (DEPTH, ATTN_WIDTH)),
        "lru_out_g": gain(ks[19], (DEPTH, LRU_WIDTH)),
        "w_out": nrm(ks[20], (DEPTH, D_MODEL, D_MODEL), D_MODEL ** -0.5),
        "norm_ffn_g": gain(ks[21], (DEPTH, D_MODEL)),
        "w_peer_q": nrm(ks[22], (DEPTH, D_MODEL, PEER_HEADS * D_KEY), D_MODEL ** -0.5),
        "peer_sub_keys": nrm(ks[23], (DEPTH, PEER_HEADS, 2, N_KEYS, D_KEY // 2), (D_KEY // 2) ** -0.5),
        "peer_u": nrm(ks[24], (DEPTH, N_EXPERTS, D_MODEL), D_MODEL ** -0.5),
        "peer_v": nrm(ks[25], (DEPTH, N_EXPERTS, D_MODEL), PEER_TOPK ** -0.5),
    }


def reference(x_prompt, x_sample, cache_k, cache_v, state_conv, state_h,
              norm_mix_g, w_in, q_norm_g, k_norm_g, attn_sinks, conv_w, conv_b,
              w_rec_gate, b_rec_gate, w_in_gate, b_in_gate, lru_lambda,
              attn_out_g, lru_out_g, w_out, norm_ffn_g, w_peer_q, peer_sub_keys,
              peer_u, peer_v):
    xp, xs = x_prompt, x_sample
    kp, vp, cp, hp, kss, vss, css, hss = [], [], [], [], [], [], [], []
    bp = xp.shape[0]
    for l in range(DEPTH):
        lw = (norm_mix_g[l], w_in[l], q_norm_g[l], k_norm_g[l], attn_sinks[l], conv_w[l], conv_b[l],
              w_rec_gate[l], b_rec_gate[l], w_in_gate[l], b_in_gate[l], lru_lambda[l],
              attn_out_g[l], lru_out_g[l], w_out[l], norm_ffn_g[l], w_peer_q[l], peer_sub_keys[l],
              peer_u[l], peer_v[l])
        xp, k1, v1, c1, h1 = _layer(
            xp, 0.0, None,
            jnp.zeros((bp, CONV_W - 1, LRU_WIDTH), xp.dtype),
            jnp.zeros((bp, LRU_WIDTH), xp.dtype), lw)
        xs, k2, v2, c2, h2 = _layer(
            xs, float(PAST_LEN), (cache_k[l], cache_v[l]), state_conv[l], state_h[l], lw)
        kp.append(k1); vp.append(v1); cp.append(c1); hp.append(h1)
        kss.append(k2); vss.append(v2); css.append(c2); hss.append(h2)
    return (xp, xs,
            jnp.stack(kp), jnp.stack(vp), jnp.stack(cp), jnp.stack(hp),
            jnp.stack(kss), jnp.stack(vss), jnp.stack(css), jnp.stack(hss))
```

```cpp
#include <hip/hip_runtime.h>
#include <hip/hip_cooperative_groups.h>
#include <cstdio>
#include <cstdint>
namespace cg = cooperative_groups;

#ifndef ONE_LAUNCH
#define ONE_LAUNCH 0
#endif

typedef unsigned short bf16_t;
using bf16x8 = __attribute__((ext_vector_type(8))) short;
using f32x4 = __attribute__((ext_vector_type(4))) float;

#define NTOK 9216
#define NPROMPT 8192
#define DM 2048
#define INW 3584
#define EPSV 1e-6f

struct Params {
  const float *x_prompt, *x_sample, *cache_k, *cache_v, *state_conv, *state_h;
  const float *g_mix, *w_in, *g_q, *g_k, *sinks, *conv_w, *conv_b, *w_a, *b_a, *w_x, *b_x, *lam;
  const float *g_ao, *g_lo, *w_out, *g_ffn, *w_pq, *sub_keys, *peer_u, *peer_v;
  float* out;
  bf16_t *w_in_t, *w_out_t, *w_pq_t, *sk_bf, *u_bf, *v_bf, *act, *qb, *kb, *vb, *pq;
  float *z, *hloc, *pc, *chA, *chU, *mixraw, *sel_g;
  int* sel_eid;
};

#define OFF_Y 0
#define OFF_KP 18874368
#define OFF_VP 18939904
#define OFF_CP 19005440
#define OFF_HP 19011584
#define OFF_KS 19013632
#define OFF_VS 23207936
#define OFF_CS 27402240
#define OFF_HS 27795456

__device__ __forceinline__ bf16_t f2bf(float f) {
  unsigned u = __float_as_uint(f);
  u += 0x7FFFu + ((u >> 16) & 1u);
  return (bf16_t)(u >> 16);
}
__device__ __forceinline__ unsigned pack2bf(float a, float b) {
  return (unsigned)f2bf(a) | ((unsigned)f2bf(b) << 16);
}
__device__ __forceinline__ float bflo(unsigned u) { return __uint_as_float(u << 16); }
__device__ __forceinline__ float bfhi(unsigned u) { return __uint_as_float(u & 0xFFFF0000u); }

__device__ __forceinline__ float wave_sum(float v) {
#pragma unroll
  for (int o = 32; o > 0; o >>= 1) v += __shfl_xor(v, o);
  return v;
}
__device__ __forceinline__ float gelu_tanh(float x) {
  float y = 0.7978845608028654f * (x + 0.044715f * x * x * x);
  float e = __expf(2.0f * y);
  float t = 1.0f - 2.0f / (e + 1.0f);
  return 0.5f * x * (1.0f + t);
}
__device__ __forceinline__ float sigmoidf_(float x) { return 1.0f / (1.0f + __expf(-x)); }

__device__ __forceinline__ const float* xrow(const Params& p, int tok) {
  return tok < NPROMPT ? p.x_prompt + (size_t)tok * DM : p.x_sample + (size_t)(tok - NPROMPT) * DM;
}

__device__ __forceinline__ void rms_row_to_bf16(const float* __restrict__ src, const float* __restrict__ g,
                                                bf16_t* __restrict__ dst, int lane) {
  float4 v[8];
  float ss = 0.f;
#pragma unroll
  for (int i = 0; i < 8; i++) {
    v[i] = *(const float4*)(src + i * 256 + lane * 4);
    ss += v[i].x * v[i].x + v[i].y * v[i].y + v[i].z * v[i].z + v[i].w * v[i].w;
  }
  ss = wave_sum(ss);
  float r = rsqrtf(ss * (1.0f / DM) + EPSV);
#pragma unroll
  for (int i = 0; i < 8; i++) {
    float4 gg = *(const float4*)(g + i * 256 + lane * 4);
    uint2 o;
    o.x = pack2bf(v[i].x * r * gg.x, v[i].y * r * gg.y);
    o.y = pack2bf(v[i].z * r * gg.z, v[i].w * r * gg.w);
    *(uint2*)(dst + i * 256 + lane * 4) = o;
  }
}

__device__ void phase_convert(const Params& p, char* smem, int bid, int nb) {
  const int tid = threadIdx.x, lane = tid & 63, wave = tid >> 6;
  float* tile = (float*)smem;
  const int T_IN = 32 * 56, T_OUT = 32 * 32, T_PQ = 32 * 32;
  for (int t = bid; t < T_IN + T_OUT + T_PQ; t += nb) {
    const float* W; bf16_t* Wt; int N; int tt = t;
    if (tt < T_IN) { W = p.w_in; Wt = p.w_in_t; N = INW; }
    else if (tt < T_IN + T_OUT) { tt -= T_IN; W = p.w_out; Wt = p.w_out_t; N = DM; }
    else { tt -= T_IN + T_OUT; W = p.w_pq; Wt = p.w_pq_t; N = DM; }
    const int ntn = N / 64;
    const int kt = tt / ntn, nt = tt % ntn;
#pragma unroll
    for (int i = 0; i < 16; i++) {
      int k = (tid >> 6) + 4 * i, n = tid & 63;
      tile[k * 65 + n] = W[(size_t)(kt * 64 + k) * N + nt * 64 + n];
    }
    __syncthreads();
#pragma unroll
    for (int i = 0; i < 16; i++) {
      int n = (tid >> 6) + 4 * i, k = tid & 63;
      Wt[(size_t)(nt * 64 + n) * DM + kt * 64 + k] = f2bf(tile[k * 65 + n]);
    }
    __syncthreads();
  }
  {
    const size_t units = (size_t)16384 * 2048 / 8;
    for (size_t i = (size_t)bid * 256 + tid; i < 2 * units; i += (size_t)nb * 256) {
      const float* src; bf16_t* dst; size_t j = i;
      if (j < units) { src = p.peer_u; dst = p.u_bf; } else { j -= units; src = p.peer_v; dst = p.v_bf; }
      float4 a = *(const float4*)(src + j * 8);
      float4 b = *(const float4*)(src + j * 8 + 4);
      uint4 o;
      o.x = pack2bf(a.x, a.y); o.y = pack2bf(a.z, a.w); o.z = pack2bf(b.x, b.y); o.w = pack2bf(b.z, b.w);
      *(uint4*)(dst + j * 8) = o;
    }
    for (int i = bid * 256 + tid; i < 262144 / 8; i += nb * 256) {
      float4 a = *(const float4*)(p.sub_keys + (size_t)i * 8);
      float4 b = *(const float4*)(p.sub_keys + (size_t)i * 8 + 4);
      uint4 o;
      o.x = pack2bf(a.x, a.y); o.y = pack2bf(a.z, a.w); o.z = pack2bf(b.x, b.y); o.w = pack2bf(b.z, b.w);
      *(uint4*)(p.sk_bf + (size_t)i * 8) = o;
    }
  }
  for (int tok = bid * 4 + wave; tok < NTOK; tok += nb * 4)
    rms_row_to_bf16(xrow(p, tok), p.g_mix, p.act + (size_t)tok * DM, lane);
  {
    const int per_b = 120 * 256 / 4;
    for (int i = bid * 256 + tid; i < 128 * per_b * 2; i += nb * 256) {
      int j = i; const float* src; float* dst;
      if (j < 128 * per_b) { src = p.cache_k; dst = p.out + OFF_KS; } else { j -= 128 * per_b; src = p.cache_v; dst = p.out + OFF_VS; }
      int b = j / per_b, r = j % per_b;
      *(float4*)(dst + (size_t)b * 32768 + r * 4) = *(const float4*)(src + (size_t)b * 32768 + 8 * 256 + r * 4);
    }
  }
}

template <int MODE>
__device__ void gemm_phase(const Params& p, char* smem, int bid, int nb, const bf16_t* __restrict__ A,
                           const bf16_t* __restrict__ Bt, const int N) {
  constexpr int K = DM;
  bf16_t* sA = (bf16_t*)smem;
  bf16_t* sB = sA + 2 * 8192;
  const int tid = threadIdx.x, lane = tid & 63, wave = tid >> 6;
  const int wm = wave >> 1, wn = wave & 1;
  const int ntn = N / 128;
  const int ntiles = (NTOK / 128) * ntn;
  const int lrow = tid >> 3, lkc = tid & 7;
  for (int t = bid; t < ntiles; t += nb) {
    const int mt = t / ntn, nt = t % ntn;
    const int m0 = mt * 128, n0 = nt * 128;
    f32x4 acc[4][4];
#pragma unroll
    for (int i = 0; i < 4; i++)
#pragma unroll
      for (int j = 0; j < 4; j++) acc[i][j] = f32x4{0.f, 0.f, 0.f, 0.f};
    uint4 ra[4], rb[4];
    const bf16_t* ga = A + (size_t)(m0 + lrow) * K + lkc * 8;
    const bf16_t* gb = Bt + (size_t)(n0 + lrow) * K + lkc * 8;
#pragma unroll
    for (int i = 0; i < 4; i++) {
      ra[i] = *(const uint4*)(ga + (size_t)i * 32 * K);
      rb[i] = *(const uint4*)(gb + (size_t)i * 32 * K);
    }
#pragma unroll
    for (int i = 0; i < 4; i++) {
      int row = lrow + i * 32;
      int off = row * 64 + ((lkc ^ (row & 7)) * 8);
      *(uint4*)(sA + off) = ra[i];
      *(uint4*)(sB + off) = rb[i];
    }
    __syncthreads();
    constexpr int KT = K / 64;
    for (int kt = 0; kt < KT; kt++) {
      const int buf = kt & 1;
      if (kt + 1 < KT) {
#pragma unroll
        for (int i = 0; i < 4; i++) {
          ra[i] = *(const uint4*)(ga + (size_t)i * 32 * K + (kt + 1) * 64);
          rb[i] = *(const uint4*)(gb + (size_t)i * 32 * K + (kt + 1) * 64);
        }
      }
      const bf16_t* cA = sA + buf * 8192;
      const bf16_t* cB = sB + buf * 8192;
#pragma unroll
      for (int ks = 0; ks < 2; ks++) {
        bf16x8 af[4], bfr[4];
        const int kc = ks * 4 + (lane >> 4);
#pragma unroll
        for (int mi = 0; mi < 4; mi++) {
          int row = wm * 64 + mi * 16 + (lane & 15);
          af[mi] = *(const bf16x8*)(cA + row * 64 + ((kc ^ (row & 7)) * 8));
        }
#pragma unroll
        for (int ni = 0; ni < 4; ni++) {
          int row = wn * 64 + ni * 16 + (lane & 15);
          bfr[ni] = *(const bf16x8*)(cB + row * 64 + ((kc ^ (row & 7)) * 8));
        }
#pragma unroll
        for (int mi = 0; mi < 4; mi++)
#pragma unroll
          for (int ni = 0; ni < 4; ni++)
            acc[mi][ni] = __builtin_amdgcn_mfma_f32_16x16x32_bf16(af[mi], bfr[ni], acc[mi][ni], 0, 0, 0);
      }
      if (kt + 1 < KT) {
        bf16_t* nA = sA + (buf ^ 1) * 8192;
        bf16_t* nB = sB + (buf ^ 1) * 8192;
#pragma unroll
        for (int i = 0; i < 4; i++) {
          int row = lrow + i * 32;
          int off = row * 64 + ((lkc ^ (row & 7)) * 8);
          *(uint4*)(nA + off) = ra[i];
          *(uint4*)(nB + off) = rb[i];
        }
      }
      __syncthreads();
    }
#pragma unroll
    for (int mi = 0; mi < 4; mi++)
#pragma unroll
      for (int j = 0; j < 4; j++) {
        const int row = m0 + wm * 64 + mi * 16 + (lane >> 4) * 4 + j;
#pragma unroll
        for (int ni = 0; ni < 4; ni++) {
          const int col = n0 + wn * 64 + ni * 16 + (lane & 15);
          const float v = acc[mi][ni][j];
          if (MODE == 0) p.z[(size_t)row * INW + col] = v;
          else if (MODE == 1) p.out[OFF_Y + (size_t)row * DM + col] = xrow(p, row)[col] + v;
          else p.pq[(size_t)row * DM + col] = f2bf(v);
        }
      }
  }
}

__device__ void phase_qkprep(const Params& p, int bid, int nb) {
  const int tid = threadIdx.x, lane = tid & 63, wave = tid >> 6;
  const float gq = p.g_q[lane], gk = p.g_k[lane];
  const float inv = expf(-9.210340371976184f * (float)(lane & 31) * (2.0f / 64.0f));
  for (int tok = bid * 4 + wave; tok < NTOK; tok += nb * 4) {
    const bool prompt = tok < NPROMPT;
    const int b = prompt ? (tok >> 12) : ((tok - NPROMPT) >> 3);
    const int t = prompt ? (tok & 4095) : ((tok - NPROMPT) & 7);
    const float pos = prompt ? (float)t : (float)(8192 + t);
    float sn, cs;
    sincosf(pos * inv, &sn, &cs);
    const float* zr = p.z + (size_t)tok * INW;
#pragma unroll 4
    for (int h = 0; h < 20; h++) {
      float v = zr[h * 64 + lane];
      float ss = wave_sum(v * v);
      float y = v * rsqrtf(ss * (1.0f / 64.0f) + EPSV) * (h < 16 ? gq : gk);
      float o = __shfl_xor(y, 32);
      float r = (lane < 32) ? (y * cs - o * sn) : (y * cs + o * sn);
      if (h < 16) {
        p.qb[(size_t)tok * 1024 + h * 64 + lane] = f2bf(r);
      } else {
        const int kh = h - 16;
        p.kb[(size_t)tok * 256 + kh * 64 + lane] = f2bf(r);
        float vv = zr[1280 + kh * 64 + lane];
        p.vb[(size_t)tok * 256 + kh * 64 + lane] = f2bf(vv);
        if (prompt) {
          if (t >= 4096 - 128) {
            size_t o2 = ((size_t)b * 128 + (t - 3968)) * 256 + kh * 64 + lane;
            p.out[OFF_KP + o2] = r;
            p.out[OFF_VP + o2] = vv;
          }
        } else {
          size_t o2 = ((size_t)b * 128 + 120 + t) * 256 + kh * 64 + lane;
          p.out[OFF_KS + o2] = r;
          p.out[OFF_VS + o2] = vv;
        }
      }
    }
  }
}

__device__ void phase_lru_local(const Params& p, char* smem, int bid, int nb) {
  const int tid = threadIdx.x, lane = tid & 63, wave = tid >> 6;
  float* sx = (float*)smem + wave * 512;
  for (int u = bid * 4 + wave; u < 4096; u += nb * 4) {
    const bool prompt = u < 2048;
    const int n = u & 15;
    const int ch = n * 64 + lane;
    int b, chunk, tok0, T;
    if (prompt) { b = u >> 10; chunk = (u >> 4) & 63; tok0 = b * 4096 + chunk * 64; T = 64; }
    else { b = (u - 2048) >> 4; chunk = 0; tok0 = NPROMPT + b * 8; T = 8; }
    float wa[64], wx[64];
#pragma unroll
    for (int d = 0; d < 64; d++) {
      wa[d] = p.w_a[(size_t)(n * 64 + d) * 64 + lane];
      wx[d] = p.w_x[(size_t)(n * 64 + d) * 64 + lane];
    }
    const float ba = p.b_a[ch], bx = p.b_x[ch], cb = p.conv_b[ch];
    const float cw0 = p.conv_w[ch], cw1 = p.conv_w[1024 + ch], cw2 = p.conv_w[2048 + ch], cw3 = p.conv_w[3072 + ch];
    const float lamv = p.lam[ch];
    const float sp = log1pf(expf(-lamv));
    float xm3 = 0.f, xm2 = 0.f, xm1 = 0.f, h = 0.f, P = 1.f;
    if (!prompt) {
      xm3 = p.state_conv[((size_t)b * 3 + 0) * 1024 + ch];
      xm2 = p.state_conv[((size_t)b * 3 + 1) * 1024 + ch];
      xm1 = p.state_conv[((size_t)b * 3 + 2) * 1024 + ch];
      h = p.state_h[(size_t)b * 1024 + ch];
    } else if (chunk > 0) {
      xm3 = p.z[(size_t)(tok0 - 3) * INW + 1536 + ch];
      xm2 = p.z[(size_t)(tok0 - 2) * INW + 1536 + ch];
      xm1 = p.z[(size_t)(tok0 - 1) * INW + 1536 + ch];
    }
#pragma unroll 1
    for (int t8 = 0; t8 < T; t8 += 4) {
      float xc[4];
#pragma unroll
      for (int i = 0; i < 4; i++) {
        float xr = p.z[(size_t)(tok0 + t8 + i) * INW + 1536 + ch];
        xc[i] = cw0 * xm3 + cw1 * xm2 + cw2 * xm1 + cw3 * xr + cb;
        xm3 = xm2; xm2 = xm1; xm1 = xr;
        sx[i * 64 + lane] = xc[i];
      }
      __builtin_amdgcn_fence(__ATOMIC_RELEASE, "wavefront");
      __builtin_amdgcn_wave_barrier();
      __builtin_amdgcn_fence(__ATOMIC_ACQUIRE, "wavefront");
#pragma unroll
      for (int i = 0; i < 4; i++) {
        float pa = ba, px = bx;
#pragma unroll
        for (int d4 = 0; d4 < 16; d4++) {
          float4 v = *(const float4*)(sx + i * 64 + d4 * 4);
          pa += wa[d4 * 4 + 0] * v.x; px += wx[d4 * 4 + 0] * v.x;
          pa += wa[d4 * 4 + 1] * v.y; px += wx[d4 * 4 + 1] * v.y;
          pa += wa[d4 * 4 + 2] * v.z; px += wx[d4 * 4 + 2] * v.z;
          pa += wa[d4 * 4 + 3] * v.w; px += wx[d4 * 4 + 3] * v.w;
        }
        float r = sigmoidf_(pa), ig = sigmoidf_(px);
        float la = -8.0f * r * sp;
        float a = expf(la);
        float mult = sqrtf(-expm1f(2.0f * la));
        float uu = mult * ig * xc[i];
        h = a * h + uu;
        P *= a;
        size_t o = (size_t)(tok0 + t8 + i) * 1024 + ch;
        p.hloc[o] = h;
        p.pc[o] = P;
      }
      __builtin_amdgcn_fence(__ATOMIC_RELEASE, "wavefront");
      __builtin_amdgcn_wave_barrier();
    }
    if (prompt) {
      p.chA[((size_t)b * 64 + chunk) * 1024 + ch] = P;
      p.chU[((size_t)b * 64 + chunk) * 1024 + ch] = h;
    }
  }
}

#define VS 264
template <int NT>
__device__ __forceinline__ void attn_qtile(const bf16_t* sK, const bf16_t* sVt, const bf16_t* qptr, const int i_idx,
                                           const int jmin, const float sink, f32x4 (&o)[4], const int lane) {
  const int r15 = lane & 15, q4 = lane >> 4;
  bf16x8 qf[2];
  qf[0] = *(const bf16x8*)(qptr);
  qf[1] = *(const bf16x8*)(qptr + 32);
  const bf16_t* kb0 = sK + r15 * 64 + ((q4 ^ (r15 & 7)) * 8);
  const bf16_t* kb1 = sK + r15 * 64 + (((4 + q4) ^ (r15 & 7)) * 8);
  f32x4 s[NT];
#pragma unroll
  for (int t = 0; t < NT; t++) {
    s[t] = f32x4{0.f, 0.f, 0.f, 0.f};
    bf16x8 a0 = *(const bf16x8*)(kb0 + t * 1024);
    bf16x8 a1 = *(const bf16x8*)(kb1 + t * 1024);
    s[t] = __builtin_amdgcn_mfma_f32_16x16x32_bf16(a0, qf[0], s[t], 0, 0, 0);
    s[t] = __builtin_amdgcn_mfma_f32_16x16x32_bf16(a1, qf[1], s[t], 0, 0, 0);
    if (t & 1) __builtin_amdgcn_sched_barrier(0);
  }
  float m = sink;
  const int jb = q4 * 4 - i_idx;
#pragma unroll
  for (int t = 0; t < NT; t++)
#pragma unroll
    for (int j = 0; j < 4; j++) {
      const int dj = t * 16 + j + jb;
      const bool valid = (dj > 0) && (dj <= 128) && (dj + i_idx >= jmin);
      float v = valid ? s[t][j] * 0.125f : -1e30f;
      s[t][j] = v;
      m = fmaxf(m, v);
    }
  m = fmaxf(m, __shfl_xor(m, 16));
  m = fmaxf(m, __shfl_xor(m, 32));
  float sum = 0.f;
#pragma unroll
  for (int t = 0; t < NT; t++)
#pragma unroll
    for (int j = 0; j < 4; j++) {
      float e = __expf(s[t][j] - m);
      s[t][j] = e;
      sum += e;
    }
  sum += __shfl_xor(sum, 16);
  sum += __shfl_xor(sum, 32);
  sum += __expf(sink - m);
  const float inv = 1.0f / sum;
  const bf16_t* vbase = sVt + r15 * VS + q4 * 4;
#pragma unroll
  for (int kk = 0; kk < NT / 2; kk++) {
    union { bf16x8 v; unsigned u[4]; } pa;
    pa.u[0] = pack2bf(s[2 * kk][0] * inv, s[2 * kk][1] * inv);
    pa.u[1] = pack2bf(s[2 * kk][2] * inv, s[2 * kk][3] * inv);
    pa.u[2] = pack2bf(s[2 * kk + 1][0] * inv, s[2 * kk + 1][1] * inv);
    pa.u[3] = pack2bf(s[2 * kk + 1][2] * inv, s[2 * kk + 1][3] * inv);
#pragma unroll
    for (int dt = 0; dt < 4; dt++) {
      union { bf16x8 v; uint2 h[2]; } bv;
      bv.h[0] = *(const uint2*)(vbase + dt * 16 * VS + kk * 32);
      bv.h[1] = *(const uint2*)(vbase + dt * 16 * VS + kk * 32 + 16);
      o[dt] = __builtin_amdgcn_mfma_f32_16x16x32_bf16(pa.v, bv.v, o[dt], 0, 0, 0);
    }
    __builtin_amdgcn_sched_barrier(0);
  }
}

__device__ __forceinline__ void kv_to_lds(bf16_t* sK, bf16_t* sVt, int key, int dc, const uint4& kv, const uint4& vv) {
  *(uint4*)(sK + key * 64 + ((dc ^ (key & 7)) * 8)) = kv;
  bf16_t* vp = sVt + (dc * 8) * VS + key;
  vp[0 * VS] = (bf16_t)(vv.x & 0xFFFF); vp[1 * VS] = (bf16_t)(vv.x >> 16);
  vp[2 * VS] = (bf16_t)(vv.y & 0xFFFF); vp[3 * VS] = (bf16_t)(vv.y >> 16);
  vp[4 * VS] = (bf16_t)(vv.z & 0xFFFF); vp[5 * VS] = (bf16_t)(vv.z >> 16);
  vp[6 * VS] = (bf16_t)(vv.w & 0xFFFF); vp[7 * VS] = (bf16_t)(vv.w >> 16);
}

__device__ void phase_attn(const Params& p, char* smem, int bid, int nb) {
  const int tid = threadIdx.x, lane = tid & 63, wave = tid >> 6;
  bf16_t* sK = (bf16_t*)smem;
  bf16_t* sVt = sK + 256 * 64;
  for (int unit = bid; unit < 1024 + 512; unit += nb) {
    __syncthreads();
    if (unit < 1024) {
      const int hq = unit & 15, n = (unit >> 4) & 31, b = unit >> 9;
      const int kvh = hq >> 2;
#pragma unroll 2
      for (int i = 0; i < 8; i++) {
        const int key = tid, dc = i;
        const int tk = n * 128 - 128 + key;
        uint4 kv = uint4{0, 0, 0, 0}, vv = uint4{0, 0, 0, 0};
        if (tk >= 0) {
          kv = *(const uint4*)(p.kb + (size_t)(b * 4096 + tk) * 256 + kvh * 64 + dc * 8);
          vv = *(const uint4*)(p.vb + (size_t)(b * 4096 + tk) * 256 + kvh * 64 + dc * 8);
        }
        kv_to_lds(sK, sVt, key, dc, kv, vv);
      }
      __syncthreads();
      const float sink = p.sinks[hq];
      const int jmin = n > 0 ? 0 : 128;
#pragma unroll 1
      for (int qt = 0; qt < 2; qt++) {
        const int i_idx = wave * 32 + qt * 16 + (lane & 15);
        const int tokq = b * 4096 + n * 128 + i_idx;
        f32x4 o[4];
#pragma unroll
        for (int dt = 0; dt < 4; dt++) o[dt] = f32x4{0.f, 0.f, 0.f, 0.f};
        attn_qtile<16>(sK, sVt, p.qb + (size_t)tokq * 1024 + hq * 64 + (lane >> 4) * 8, i_idx, jmin, sink, o, lane);
        const int tokbase = b * 4096 + n * 128 + wave * 32 + qt * 16;
        float* op = p.mixraw + (size_t)(tokbase + (lane >> 4) * 4) * DM + hq * 64 + (lane & 15);
#pragma unroll
        for (int dt = 0; dt < 4; dt++)
#pragma unroll
          for (int j = 0; j < 4; j++) op[(size_t)j * DM + dt * 16] = o[dt][j];
      }
    } else {
      const int us = unit - 1024;
      const int kvh = us & 3, b = us >> 2;
#pragma unroll 1
      for (int i = 0; i < 5; i++) {
        const int id = tid + i * 256;
        const int key = id % 160, dc = id / 160;
        uint4 kv = uint4{0, 0, 0, 0}, vv = uint4{0, 0, 0, 0};
        if (key < 128) {
          const float* ck = p.cache_k + (((size_t)b * 128 + key) * 4 + kvh) * 64 + dc * 8;
          const float* cv = p.cache_v + (((size_t)b * 128 + key) * 4 + kvh) * 64 + dc * 8;
          float4 a0 = *(const float4*)ck, a1 = *(const float4*)(ck + 4);
          float4 b0 = *(const float4*)cv, b1 = *(const float4*)(cv + 4);
          kv.x = pack2bf(a0.x, a0.y); kv.y = pack2bf(a0.z, a0.w); kv.z = pack2bf(a1.x, a1.y); kv.w = pack2bf(a1.z, a1.w);
          vv.x = pack2bf(b0.x, b0.y); vv.y = pack2bf(b0.z, b0.w); vv.z = pack2bf(b1.x, b1.y); vv.w = pack2bf(b1.z, b1.w);
        } else if (key < 136) {
          kv = *(const uint4*)(p.kb + (size_t)(NPROMPT + b * 8 + key - 128) * 256 + kvh * 64 + dc * 8);
          vv = *(const uint4*)(p.vb + (size_t)(NPROMPT + b * 8 + key - 128) * 256 + kvh * 64 + dc * 8);
        }
        kv_to_lds(sK, sVt, key, dc, kv, vv);
      }
      __syncthreads();
      if (wave < 2) {
        const int r = lane & 15;
        const int hq = kvh * 4 + wave * 2 + (r >> 3);
        const int s_idx = r & 7;
        const int tokq = NPROMPT + b * 8 + s_idx;
        f32x4 o[4];
#pragma unroll
        for (int dt = 0; dt < 4; dt++) o[dt] = f32x4{0.f, 0.f, 0.f, 0.f};
        attn_qtile<10>(sK, sVt, p.qb + (size_t)tokq * 1024 + hq * 64 + (lane >> 4) * 8, s_idx, 0, p.sinks[hq], o, lane);
#pragma unroll
        for (int j = 0; j < 4; j++) {
          const int rr = (lane >> 4) * 4 + j;
          const int hq2 = kvh * 4 + wave * 2 + (rr >> 3);
          float* op = p.mixraw + (size_t)(NPROMPT + b * 8 + (rr & 7)) * DM + hq2 * 64 + (lane & 15);
#pragma unroll
          for (int dt = 0; dt < 4; dt++) op[dt * 16] = o[dt][j];
        }
      }
    }
  }
}

__device__ void phase_lru_apply(const Params& p, int bid, int nb) {
  const int tid = threadIdx.x, lane = tid & 63, wave = tid >> 6;
  for (int u = bid * 4 + wave; u < 4096; u += nb * 4) {
    const bool prompt = u < 2048;
    const int n = u & 15;
    const int ch = n * 64 + lane;
    int b, chunk, tok0, T;
    if (prompt) { b = u >> 10; chunk = (u >> 4) & 63; tok0 = b * 4096 + chunk * 64; T = 64; }
    else { b = (u - 2048) >> 4; chunk = 0; tok0 = NPROMPT + b * 8; T = 8; }
    float hin = 0.f;
    if (prompt)
      for (int k = 0; k < chunk; k++)
        hin = p.chA[((size_t)b * 64 + k) * 1024 + ch] * hin + p.chU[((size_t)b * 64 + k) * 1024 + ch];
    float h = 0.f;
#pragma unroll 4
    for (int t = 0; t < T; t++) {
      const size_t tok = tok0 + t;
      h = p.hloc[tok * 1024 + ch] + p.pc[tok * 1024 + ch] * hin;
      float yg = p.z[tok * INW + 2560 + ch];
      p.mixraw[tok * DM + 1024 + ch] = h * gelu_tanh(yg);
    }
    if (prompt) {
      if (chunk == 63) {
        p.out[OFF_HP + (size_t)b * 1024 + ch] = h;
#pragma unroll
        for (int j = 0; j < 3; j++)
          p.out[OFF_CP + ((size_t)b * 3 + j) * 1024 + ch] = p.z[(size_t)(b * 4096 + 4093 + j) * INW + 1536 + ch];
      }
    } else {
      p.out[OFF_HS + (size_t)b * 1024 + ch] = h;
#pragma unroll
      for (int j = 0; j < 3; j++)
        p.out[OFF_CS + ((size_t)b * 3 + j) * 1024 + ch] = p.z[(size_t)(NPROMPT + b * 8 + 5 + j) * INW + 1536 + ch];
    }
  }
}

__device__ void phase_mixnorm(const Params& p, int bid, int nb) {
  const int tid = threadIdx.x, lane = tid & 63, wave = tid >> 6;
  for (int tok = bid * 4 + wave; tok < NTOK; tok += nb * 4) {
    const float* src = p.mixraw + (size_t)tok * DM;
    float4 v[8];
    float sa = 0.f, sl = 0.f;
#pragma unroll
    for (int i = 0; i < 8; i++) {
      v[i] = *(const float4*)(src + i * 256 + lane * 4);
      float q = v[i].x * v[i].x + v[i].y * v[i].y + v[i].z * v[i].z + v[i].w * v[i].w;
      if (i < 4) sa += q; else sl += q;
    }
    sa = wave_sum(sa); sl = wave_sum(sl);
    const float ra = rsqrtf(sa * (1.0f / 1024.0f) + EPSV), rl = rsqrtf(sl * (1.0f / 1024.0f) + EPSV);
    bf16_t* dst = p.act + (size_t)tok * DM;
#pragma unroll
    for (int i = 0; i < 8; i++) {
      const int c = i * 256 + lane * 4;
      float4 gg = (i < 4) ? *(const float4*)(p.g_ao + c) : *(const float4*)(p.g_lo + c - 1024);
      const float r = (i < 4) ? ra : rl;
      uint2 o;
      o.x = pack2bf(v[i].x * r * gg.x, v[i].y * r * gg.y);
      o.y = pack2bf(v[i].z * r * gg.z, v[i].w * r * gg.w);
      *(uint2*)(dst + c) = o;
    }
  }
}

__device__ void phase_ffnnorm(const Params& p, int bid, int nb) {
  const int tid = threadIdx.x, lane = tid & 63, wave = tid >> 6;
  for (int tok = bid * 4 + wave; tok < NTOK; tok += nb * 4)
    rms_row_to_bf16(p.out + OFF_Y + (size_t)tok * DM, p.g_ffn, p.act + (size_t)tok * DM, lane);
}

__device__ __forceinline__ int ordf(float f) { int b = __float_as_int(f); return b ^ ((b >> 31) & 0x7FFFFFFF); }
__device__ __forceinline__ float unordf(int o) { return __int_as_float(o ^ ((o >> 31) & 0x7FFFFFFF)); }
template <int CTRL>
__device__ __forceinline__ int dppi(int v) { return __builtin_amdgcn_update_dpp(v, v, CTRL, 0xF, 0xF, false); }
__device__ __forceinline__ int row16_allmax(int m) {
  m = max(m, dppi<0xB1>(m));
  m = max(m, dppi<0x4E>(m));
  m = max(m, dppi<0x141>(m));
  m = max(m, dppi<0x140>(m));
  return m;
}
__device__ __forceinline__ int quad_allmax(int m) {
  m = max(m, dppi<0xB1>(m));
  m = max(m, dppi<0x4E>(m));
  return m;
}

__device__ void phase_peer_select(const Params& p, char* smem, int bid, int nb) {
  const int tid = threadIdx.x, lane = tid & 63, wave = tid >> 6;
  int* tab = (int*)smem;
  int* st = tab + 64 + wave * 512;
  if (tid < 64) {
    int e = -1, cnt = 0;
    for (int i = 0; i < 16; i++) {
      int nn = 16 / (i + 1);
      if (tid >= cnt && tid < cnt + nn) e = i | ((tid - cnt) << 4);
      cnt += nn;
    }
    tab[tid] = e;
  }
  __syncthreads();
  const int r15 = lane & 15, q4 = lane >> 4;
  for (int unit = bid * 4 + wave; unit < 576 * 8; unit += nb * 4) {
    const int tt = unit >> 3, hh = unit & 7;
#pragma unroll 1
    for (int c = 0; c < 2; c++) {
      f32x4 acc[8];
#pragma unroll
      for (int kt = 0; kt < 8; kt++) acc[kt] = f32x4{0.f, 0.f, 0.f, 0.f};
      const bf16_t* arow = p.pq + (size_t)(tt * 16 + r15) * DM + hh * 256 + c * 128 + q4 * 8;
      const bf16_t* brow = p.sk_bf + ((size_t)((hh * 2 + c) * 128 + r15)) * 128 + q4 * 8;
#pragma unroll
      for (int ks = 0; ks < 4; ks++) {
        bf16x8 a = *(const bf16x8*)(arow + ks * 32);
#pragma unroll
        for (int kt = 0; kt < 8; kt++) {
          bf16x8 bb = *(const bf16x8*)(brow + kt * 16 * 128 + ks * 32);
          acc[kt] = __builtin_amdgcn_mfma_f32_16x16x32_bf16(a, bb, acc[kt], 0, 0, 0);
        }
      }
      int key[8][4];
#pragma unroll
      for (int kt = 0; kt < 8; kt++)
#pragma unroll
        for (int j = 0; j < 4; j++) key[kt][j] = (ordf(acc[kt][j]) & ~127) | (127 - (kt * 16 + r15));
      int top[4] = {INT32_MIN, INT32_MIN, INT32_MIN, INT32_MIN};
#pragma unroll 1
      for (int it = 0; it < 16; it++) {
#pragma unroll
        for (int j = 0; j < 4; j++) {
          int m = key[0][j];
#pragma unroll
          for (int kt = 1; kt < 8; kt++) m = max(m, key[kt][j]);
          m = row16_allmax(m);
#pragma unroll
          for (int kt = 0; kt < 8; kt++) key[kt][j] = (key[kt][j] == m) ? INT32_MIN : key[kt][j];
          top[j] = (r15 == it) ? m : top[j];
        }
      }
#pragma unroll
      for (int j = 0; j < 4; j++) st[c * 256 + (q4 * 4 + j) * 16 + r15] = top[j];
    }
    __builtin_amdgcn_fence(__ATOMIC_RELEASE, "wavefront");
    __builtin_amdgcn_wave_barrier();
    __builtin_amdgcn_fence(__ATOMIC_ACQUIRE, "wavefront");
    const int tl = lane >> 2, sub = lane & 3;
    int ck[13];
#pragma unroll
    for (int q = 0; q < 13; q++) {
      const int pidx = sub + 4 * q;
      const int e = tab[pidx];
      int kv = INT32_MIN;
      if (e >= 0) {
        int ka = st[tl * 16 + (e & 15)];
        int kb2 = st[256 + tl * 16 + (e >> 4)];
        float s = unordf(ka & ~127) + unordf(kb2 & ~127);
        kv = (ordf(s) & ~63) | pidx;
      }
      ck[q] = kv;
    }
    int mine[4] = {0, 0, 0, 0};
    int m0 = 0;
#pragma unroll
    for (int r = 0; r < 16; r++) {
      int m = ck[0];
#pragma unroll
      for (int q = 1; q < 13; q++) m = max(m, ck[q]);
      m = quad_allmax(m);
#pragma unroll
      for (int q = 0; q < 13; q++) ck[q] = (ck[q] == m) ? INT32_MIN : ck[q];
      if (r == 0) m0 = m;
      mine[r >> 2] = (sub == (r & 3)) ? m : mine[r >> 2];
    }
    const float mx = unordf(m0 & ~63);
    float ev[4];
    float sum = 0.f;
#pragma unroll
    for (int k = 0; k < 4; k++) { ev[k] = __expf(unordf(mine[k] & ~63) - mx); sum += ev[k]; }
    sum += __shfl_xor(sum, 1);
    sum += __shfl_xor(sum, 2);
    const float inv = 1.0f / sum;
#pragma unroll
    for (int k = 0; k < 4; k++) {
      const int e = tab[mine[k] & 63];
      const int ia = 127 - (st[tl * 16 + (e & 15)] & 127);
      const int ib = 127 - (st[256 + tl * 16 + (e >> 4)] & 127);
      const size_t o = (size_t)(tt * 16 + tl) * 128 + hh * 16 + k * 4 + sub;
      p.sel_eid[o] = ia * 128 + ib;
      p.sel_g[o] = ev[k] * inv;
    }
    __builtin_amdgcn_fence(__ATOMIC_RELEASE, "wavefront");
    __builtin_amdgcn_wave_barrier();
  }
}

__device__ __forceinline__ float dot8(const uint4& r, const float* h) {
  return bflo(r.x) * h[0] + bfhi(r.x) * h[1] + bflo(r.y) * h[2] + bfhi(r.y) * h[3] + bflo(r.z) * h[4] +
         bfhi(r.z) * h[5] + bflo(r.w) * h[6] + bfhi(r.w) * h[7];
}
__device__ __forceinline__ void axpy8(float w, const uint4& r, float* f) {
  f[0] += w * bflo(r.x); f[1] += w * bfhi(r.x); f[2] += w * bflo(r.y); f[3] += w * bfhi(r.y);
  f[4] += w * bflo(r.z); f[5] += w * bfhi(r.z); f[6] += w * bflo(r.w); f[7] += w * bfhi(r.w);
}

__device__ void phase_peer_experts(const Params& p, int bid, int nb) {
  const int tid = threadIdx.x, lane = tid & 63;
  const int wave = __builtin_amdgcn_readfirstlane(tid >> 6);
  for (int tok = bid * 4 + wave; tok < NTOK; tok += nb * 4) {
    const bf16_t* hrow = p.act + (size_t)tok * DM;
    float hv[32], f[32];
#pragma unroll
    for (int c = 0; c < 4; c++) {
      uint4 raw = *(const uint4*)(hrow + c * 512 + lane * 8);
      hv[c * 8 + 0] = bflo(raw.x); hv[c * 8 + 1] = bfhi(raw.x); hv[c * 8 + 2] = bflo(raw.y); hv[c * 8 + 3] = bfhi(raw.y);
      hv[c * 8 + 4] = bflo(raw.z); hv[c * 8 + 5] = bfhi(raw.z); hv[c * 8 + 6] = bflo(raw.w); hv[c * 8 + 7] = bfhi(raw.w);
    }
#pragma unroll
    for (int i = 0; i < 32; i++) f[i] = 0.f;
    const int* eids = p.sel_eid + (size_t)tok * 128;
    const float* gs = p.sel_g + (size_t)tok * 128;
#pragma unroll 1
    for (int g4 = 0; g4 < 32; g4++) {
      int e[4]; float gg[4];
#pragma unroll
      for (int i = 0; i < 4; i++) { e[i] = eids[g4 * 4 + i]; gg[i] = gs[g4 * 4 + i]; }
      uint4 ur[4][4], vr[4][4];
#pragma unroll
      for (int i = 0; i < 4; i++)
#pragma unroll
        for (int c = 0; c < 4; c++) ur[i][c] = *(const uint4*)(p.u_bf + (size_t)e[i] * DM + c * 512 + lane * 8);
#pragma unroll
      for (int i = 0; i < 4; i++)
#pragma unroll
        for (int c = 0; c < 4; c++) vr[i][c] = *(const uint4*)(p.v_bf + (size_t)e[i] * DM + c * 512 + lane * 8);
      float d[4];
#pragma unroll
      for (int i = 0; i < 4; i++) {
        d[i] = 0.f;
#pragma unroll
        for (int c = 0; c < 4; c++) d[i] += dot8(ur[i][c], hv + c * 8);
      }
#pragma unroll
      for (int i = 0; i < 4; i++) d[i] = wave_sum(d[i]);
#pragma unroll
      for (int i = 0; i < 4; i++) {
        const float w = gelu_tanh(d[i]) * gg[i];
#pragma unroll
        for (int c = 0; c < 4; c++) axpy8(w, vr[i][c], f + c * 8);
      }
    }
    float* orow = p.out + OFF_Y + (size_t)tok * DM;
#pragma unroll
    for (int c = 0; c < 4; c++) {
      float4 a = *(float4*)(orow + c * 512 + lane * 8);
      float4 b = *(float4*)(orow + c * 512 + lane * 8 + 4);
      a.x += f[c * 8 + 0]; a.y += f[c * 8 + 1]; a.z += f[c * 8 + 2]; a.w += f[c * 8 + 3];
      b.x += f[c * 8 + 4]; b.y += f[c * 8 + 5]; b.z += f[c * 8 + 6]; b.w += f[c * 8 + 7];
      *(float4*)(orow + c * 512 + lane * 8) = a;
      *(float4*)(orow + c * 512 + lane * 8 + 4) = b;
    }
  }
}

#define NPHASE 10
__device__ __forceinline__ void run_phase(const Params& p, char* smem, int ph, int bid, int nb) {
  switch (ph) {
    case 0: phase_convert(p, smem, bid, nb); break;
    case 1: gemm_phase<0>(p, smem, bid, nb, p.act, p.w_in_t, INW); break;
    case 2: phase_qkprep(p, bid, nb); phase_lru_local(p, smem, bid, nb); break;
    case 3: phase_attn(p, smem, bid, nb); phase_lru_apply(p, bid, nb); break;
    case 4: phase_mixnorm(p, bid, nb); break;
    case 5: gemm_phase<1>(p, smem, bid, nb, p.act, p.w_out_t, DM); break;
    case 6: phase_ffnnorm(p, bid, nb); break;
    case 7: gemm_phase<2>(p, smem, bid, nb, p.act, p.w_pq_t, DM); break;
    case 8: phase_peer_select(p, smem, bid, nb); break;
    case 9: phase_peer_experts(p, bid, nb); break;
  }
}

__global__ void __launch_bounds__(256, 2) k_phase(Params p, int ph) {
  __shared__ __attribute__((aligned(16))) char smem[66560];
  run_phase(p, smem, ph, blockIdx.x, gridDim.x);
}

#if ONE_LAUNCH
__global__ void __launch_bounds__(256, 2) k_mega(Params p) {
  __shared__ __attribute__((aligned(16))) char smem[66560];
  cg::grid_group grid = cg::this_grid();
  for (int ph = 0; ph < NPHASE; ph++) {
    run_phase(p, smem, ph, blockIdx.x, gridDim.x);
    if (ph + 1 < NPHASE) grid.sync();
  }
}
#endif

extern "C" void kernel_launch(void* const* d_in, const int* in_sizes, int n_in, void* d_out, int out_size, void* d_ws,
                              size_t ws_size, hipStream_t stream) {
  Params p{};
  const float* const* in = (const float* const*)d_in;
  p.x_prompt = in[0]; p.x_sample = in[1]; p.cache_k = in[2]; p.cache_v = in[3]; p.state_conv = in[4]; p.state_h = in[5];
  p.g_mix = in[6]; p.w_in = in[7]; p.g_q = in[8]; p.g_k = in[9]; p.sinks = in[10]; p.conv_w = in[11]; p.conv_b = in[12];
  p.w_a = in[13]; p.b_a = in[14]; p.w_x = in[15]; p.b_x = in[16]; p.lam = in[17]; p.g_ao = in[18]; p.g_lo = in[19];
  p.w_out = in[20]; p.g_ffn = in[21]; p.w_pq = in[22]; p.sub_keys = in[23]; p.peer_u = in[24]; p.peer_v = in[25];
  p.out = (float*)d_out;
  char* w = (char*)d_ws;
  size_t off = 0;
  auto take = [&](size_t bytes) { char* r = w + off; off += (bytes + 255) & ~(size_t)255; return r; };
  p.w_in_t = (bf16_t*)take((size_t)INW * DM * 2);
  p.w_out_t = (bf16_t*)take((size_t)DM * DM * 2);
  p.w_pq_t = (bf16_t*)take((size_t)DM * DM * 2);
  p.sk_bf = (bf16_t*)take((size_t)262144 * 2);
  p.u_bf = (bf16_t*)take((size_t)16384 * DM * 2);
  p.v_bf = (bf16_t*)take((size_t)16384 * DM * 2);
  p.act = (bf16_t*)take((size_t)NTOK * DM * 2);
  p.z = (float*)take((size_t)NTOK * INW * 4);
  p.qb = (bf16_t*)take((size_t)NTOK * 1024 * 2);
  p.kb = (bf16_t*)take((size_t)NTOK * 256 * 2);
  p.vb = (bf16_t*)take((size_t)NTOK * 256 * 2);
  p.hloc = (float*)take((size_t)NTOK * 1024 * 4);
  p.pc = (float*)take((size_t)NTOK * 1024 * 4);
  p.chA = (float*)take((size_t)2 * 64 * 1024 * 4);
  p.chU = (float*)take((size_t)2 * 64 * 1024 * 4);
  p.mixraw = (float*)take((size_t)NTOK * DM * 4);
  p.pq = (bf16_t*)p.z;
  p.sel_eid = (int*)((char*)p.z + (size_t)NTOK * DM * 2);
  p.sel_g = (float*)((char*)p.z + (size_t)NTOK * DM * 2 + (size_t)NTOK * 128 * 4);
  if (off > ws_size) { fprintf(stderr, "workspace too small: need %zu have %zu\n", off, ws_size); return; }

  static int grid_blocks = 0;
  if (!grid_blocks) {
    int dev = 0, cus = 0, per_cu = 0;
    (void)hipGetDevice(&dev);
    (void)hipDeviceGetAttribute(&cus, hipDeviceAttributeMultiprocessorCount, dev);
#if ONE_LAUNCH
    (void)hipOccupancyMaxActiveBlocksPerMultiprocessor(&per_cu, k_mega, 256, 0);
#else
    (void)hipOccupancyMaxActiveBlocksPerMultiprocessor(&per_cu, k_phase, 256, 0);
#endif
    if (per_cu > 2) per_cu = 2;
    if (per_cu < 1) per_cu = 1;
    grid_blocks = cus * per_cu;
  }
#if ONE_LAUNCH
  void* args[] = {&p};
  hipError_t e = hipLaunchCooperativeKernel((void*)k_mega, dim3(grid_blocks), dim3(256), args, 0, stream);
  if (e != hipSuccess) fprintf(stderr, "cooperative launch failed: %s (grid %d)\n", hipGetErrorString(e), grid_blocks);
#else
  for (int ph = 0; ph < NPHASE; ph++) k_phase<<<grid_blocks, 256, 0, stream>>>(p, ph);
#endif
}
```

```cpp
#include <hip/hip_runtime.h>
#include <hip/hip_cooperative_groups.h>
#include <cstdio>
#include <cstdint>
namespace cg = cooperative_groups;

#ifndef ONE_LAUNCH
#define ONE_LAUNCH 1
#endif

typedef unsigned short bf16_t;
using bf16x8 = __attribute__((ext_vector_type(8))) short;
using f32x4 = __attribute__((ext_vector_type(4))) float;
using f32x2 = __attribute__((ext_vector_type(2))) float;
using u32x4 = __attribute__((ext_vector_type(4))) unsigned;
using i32x8 = __attribute__((ext_vector_type(8))) int;
using f32x8 = __attribute__((ext_vector_type(8))) float;

#define NTOK 9216
#define NPROMPT 8192
#define DM 2048
#define INW 3584
#define EPSV 1e-6f

struct Params {
  const float *x_prompt, *x_sample, *cache_k, *cache_v, *state_conv, *state_h;
  const float *g_mix, *w_in, *g_q, *g_k, *sinks, *conv_w, *conv_b, *w_a, *b_a, *w_x, *b_x, *lam;
  const float *g_ao, *g_lo, *w_out, *g_ffn, *w_pq, *sub_keys, *peer_u, *peer_v;
  float* out;
  bf16_t *w_in_t, *w_out_t, *w_pq_t, *wg_t, *sk_bf, *act, *qb, *kb, *vb, *pq;
  float *z, *hloc, *pc, *chA, *chU, *mixraw, *sel_g;
  int* sel_eid;
  float* pd;
  bf16_t* zb;
  float* ssq;
  bf16_t* act2;
  unsigned char *u8, *v8;
  unsigned* bar;
};

#define OFF_Y 0
#define OFF_KP 18874368
#define OFF_VP 18939904
#define OFF_CP 19005440
#define OFF_HP 19011584
#define OFF_KS 19013632
#define OFF_VS 23207936
#define OFF_CS 27402240
#define OFF_HS 27795456

__device__ __forceinline__ int opaque_tid() { int t = threadIdx.x; asm volatile("" : "+v"(t)); return t; }
__device__ __forceinline__ bf16_t f2bf(float f) {
  unsigned u = __float_as_uint(f);
  u += 0x7FFFu + ((u >> 16) & 1u);
  return (bf16_t)(u >> 16);
}
__device__ __forceinline__ unsigned pack2bf(float a, float b) {
  return (unsigned)f2bf(a) | ((unsigned)f2bf(b) << 16);
}
__device__ __forceinline__ float bf2f_(bf16_t b) { return __uint_as_float((unsigned)b << 16); }
__device__ __forceinline__ float bflo(unsigned u) { return __uint_as_float(u << 16); }
__device__ __forceinline__ float bfhi(unsigned u) { return __uint_as_float(u & 0xFFFF0000u); }

__device__ __forceinline__ float wave_sum(float v) {
#pragma unroll
  for (int o = 32; o > 0; o >>= 1) v += __shfl_xor(v, o);
  return v;
}
__device__ __forceinline__ float row16_sum(float v) {
  v += __int_as_float(__builtin_amdgcn_update_dpp(0, __float_as_int(v), 0xB1, 0xF, 0xF, false));
  v += __int_as_float(__builtin_amdgcn_update_dpp(0, __float_as_int(v), 0x4E, 0xF, 0xF, false));
  v += __int_as_float(__builtin_amdgcn_update_dpp(0, __float_as_int(v), 0x141, 0xF, 0xF, false));
  v += __int_as_float(__builtin_amdgcn_update_dpp(0, __float_as_int(v), 0x140, 0xF, 0xF, false));
  return v;
}
__device__ __forceinline__ float gelu_tanh(float x) {
  float y = 0.7978845608028654f * (x + 0.044715f * x * x * x);
  float e = __expf(2.0f * y);
  float t = 1.0f - 2.0f / (e + 1.0f);
  return 0.5f * x * (1.0f + t);
}
__device__ __forceinline__ float sigmoidf_(float x) { return 1.0f / (1.0f + __expf(-x)); }

__device__ __forceinline__ const float* xrow(const Params& p, int tok) {
  return tok < NPROMPT ? p.x_prompt + (size_t)tok * DM : p.x_sample + (size_t)(tok - NPROMPT) * DM;
}

__device__ __forceinline__ void rms_row_to_bf16(const float* __restrict__ src, const float* __restrict__ g,
                                                bf16_t* __restrict__ dst, int lane) {
  float4 v[8];
  float ss = 0.f;
#pragma unroll
  for (int i = 0; i < 8; i++) {
    v[i] = *(const float4*)(src + i * 256 + lane * 4);
    ss += v[i].x * v[i].x + v[i].y * v[i].y + v[i].z * v[i].z + v[i].w * v[i].w;
  }
  ss = wave_sum(ss);
  float r = rsqrtf(ss * (1.0f / DM) + EPSV);
#pragma unroll
  for (int i = 0; i < 8; i++) {
    float4 gg = *(const float4*)(g + i * 256 + lane * 4);
    uint2 o;
    o.x = pack2bf(v[i].x * r * gg.x, v[i].y * r * gg.y);
    o.y = pack2bf(v[i].z * r * gg.z, v[i].w * r * gg.w);
    *(uint2*)(dst + i * 256 + lane * 4) = o;
  }
}

__device__ void convert_table_fp8(const float* __restrict__ src, unsigned char* __restrict__ dst, const float sc, int worker, int nworkers, const float* __restrict__ colg) {
  const int tid = opaque_tid();
  const size_t units = (size_t)16384 * 2048 / 16;
  const size_t stride = (size_t)nworkers * 256;
  for (size_t i = (size_t)worker * 256 + tid; i < units; i += 2 * stride) {
    const size_t j1 = (i + stride < units) ? i + stride : i;
    f32x4 a0[4], a1[4];
#pragma unroll
    for (int q = 0; q < 4; q++) a0[q] = __builtin_nontemporal_load((const f32x4*)(src + i * 16 + q * 4));
#pragma unroll
    for (int q = 0; q < 4; q++) a1[q] = __builtin_nontemporal_load((const f32x4*)(src + j1 * 16 + q * 4));
    if (colg) {
#pragma unroll
      for (int q = 0; q < 4; q++) {
        const f32x4 g0 = *(const f32x4*)(colg + ((i * 16 + q * 4) & 2047));
        const f32x4 g1 = *(const f32x4*)(colg + ((j1 * 16 + q * 4) & 2047));
        a0[q] *= g0; a1[q] *= g1;
      }
    }
    u32x4 o0, o1;
#pragma unroll
    for (int q = 0; q < 4; q++) {
      int w = 0;
      w = __builtin_amdgcn_cvt_pk_fp8_f32(fminf(fmaxf(a0[q][0] * sc, -448.f), 448.f), fminf(fmaxf(a0[q][1] * sc, -448.f), 448.f), w, false);
      w = __builtin_amdgcn_cvt_pk_fp8_f32(fminf(fmaxf(a0[q][2] * sc, -448.f), 448.f), fminf(fmaxf(a0[q][3] * sc, -448.f), 448.f), w, true);
      o0[q] = (unsigned)w;
      int w1 = 0;
      w1 = __builtin_amdgcn_cvt_pk_fp8_f32(fminf(fmaxf(a1[q][0] * sc, -448.f), 448.f), fminf(fmaxf(a1[q][1] * sc, -448.f), 448.f), w1, false);
      w1 = __builtin_amdgcn_cvt_pk_fp8_f32(fminf(fmaxf(a1[q][2] * sc, -448.f), 448.f), fminf(fmaxf(a1[q][3] * sc, -448.f), 448.f), w1, true);
      o1[q] = (unsigned)w1;
    }
    *(u32x4*)(dst + i * 16) = o0;
    *(u32x4*)(dst + j1 * 16) = o1;
  }
}

__device__ void copy_cache_rows(const Params& p, int bid, int nb) {
  const int tid = opaque_tid();
  {
    const int per_b = 120 * 256 / 4;
    const int half = 128 * per_b, quarter = half / 2;
    for (int i = bid * 256 + tid; i < quarter; i += nb * 256) {
      const int j0 = i, j1 = i + quarter;
      const int b0 = j0 / per_b, r0 = j0 % per_b, b1 = j1 / per_b, r1 = j1 % per_b;
      const size_t s0 = (size_t)b0 * 32768 + 8 * 256 + r0 * 4, s1 = (size_t)b1 * 32768 + 8 * 256 + r1 * 4;
      const size_t d0 = (size_t)b0 * 32768 + r0 * 4, d1 = (size_t)b1 * 32768 + r1 * 4;
      const f32x4 v0 = *(const f32x4*)(p.cache_k + s0);
      const f32x4 v1 = *(const f32x4*)(p.cache_k + s1);
      const f32x4 v2 = *(const f32x4*)(p.cache_v + s0);
      const f32x4 v3 = *(const f32x4*)(p.cache_v + s1);
      *(f32x4*)(p.out + OFF_KS + d0) = v0;
      *(f32x4*)(p.out + OFF_KS + d1) = v1;
      *(f32x4*)(p.out + OFF_VS + d0) = v2;
      *(f32x4*)(p.out + OFF_VS + d1) = v3;
    }
  }
}

__device__ void phase_convert(const Params& p, char* smem, int bid, int nb) {
  const int tid = opaque_tid(), lane = tid & 63, wave = tid >> 6;
  float* tile = (float*)smem;
  const int T_IN = 32 * 56, T_OUT = 32 * 32, T_PQ = 32 * 32;
  for (int t = bid; t < T_IN + T_OUT + T_PQ; t += nb) {
    const float* W; bf16_t* Wt; int N; int tt = t;
    int gsel;
    if (tt < T_IN) { W = p.w_in; Wt = p.w_in_t; N = INW; gsel = 0; }
    else if (tt < T_IN + T_OUT) { tt -= T_IN; W = p.w_out; Wt = p.w_out_t; N = DM; gsel = 1; }
    else { tt -= T_IN + T_OUT; W = p.w_pq; Wt = p.w_pq_t; N = DM; gsel = 2; }
    const int ntn = N / 64;
    const int kt = tt / ntn, nt = tt % ntn;
    {
      const int krow = tid >> 4, nq = tid & 15;
      float4 v[4];
#pragma unroll
      for (int i = 0; i < 4; i++) v[i] = *(const float4*)(W + (size_t)(kt * 64 + krow + 16 * i) * N + nt * 64 + nq * 4);
#pragma unroll
      for (int i = 0; i < 4; i++) {
        const int kk = kt * 64 + krow + 16 * i;
        const float gk = (gsel == 0) ? 1.0f : (gsel == 2) ? p.g_ffn[kk] : (kk < 1024 ? p.g_ao[kk] : p.g_lo[kk - 1024]);
        float* tp = tile + (krow + 16 * i) * 65 + nq * 4;
        tp[0] = v[i].x * gk; tp[1] = v[i].y * gk; tp[2] = v[i].z * gk; tp[3] = v[i].w * gk;
      }
    }
    __syncthreads();
    {
      const int n = tid >> 2, kq = tid & 3;
      u32x4 o0, o1;
#pragma unroll
      for (int e = 0; e < 4; e++) {
        o0[e] = pack2bf(tile[(kq * 16 + 2 * e) * 65 + n], tile[(kq * 16 + 2 * e + 1) * 65 + n]);
        o1[e] = pack2bf(tile[(kq * 16 + 8 + 2 * e) * 65 + n], tile[(kq * 16 + 8 + 2 * e + 1) * 65 + n]);
      }
      bf16_t* wp = Wt + (size_t)(nt * 64 + n) * DM + kt * 64 + kq * 16;
      *(u32x4*)(wp) = o0;
      *(u32x4*)(wp + 8) = o1;
    }
    __syncthreads();
  }
  {
    for (int i = bid * 256 + tid; i < 262144 / 8; i += nb * 256) {
      float4 a = *(const float4*)(p.sub_keys + (size_t)i * 8);
      float4 b = *(const float4*)(p.sub_keys + (size_t)i * 8 + 4);
      uint4 o;
      o.x = pack2bf(a.x, a.y); o.y = pack2bf(a.z, a.w); o.z = pack2bf(b.x, b.y); o.w = pack2bf(b.z, b.w);
      *(uint4*)(p.sk_bf + (size_t)i * 8) = o;
    }
  }
  for (int i = bid * 256 + tid; i < 3 * NTOK; i += nb * 256) p.ssq[i] = 0.f;
  for (int i = bid * 256 + tid; i < 131072; i += nb * 256) {
    const int d = i & 63, e = (i >> 6) & 63, n = (i >> 12) & 15, g = i >> 16;
    const float* W = g ? p.w_x : p.w_a;
    p.wg_t[i] = f2bf(W[(size_t)(n * 64 + d) * 64 + e]);
  }
  for (int tok = bid * 4 + wave; tok < NTOK; tok += nb * 4)
    rms_row_to_bf16(xrow(p, tok), p.g_mix, p.act + (size_t)tok * DM, lane);
}

#define GEMM_GLOAD(S, koff)                                          \
  S##a0 = *(const u32x4*)(ga + (koff));                              \
  S##a1 = *(const u32x4*)(ga + (koff) + (size_t)32 * DM);            \
  S##a2 = *(const u32x4*)(ga + (koff) + (size_t)64 * DM);            \
  if (MI == 4) S##a3 = *(const u32x4*)(ga + (koff) + (size_t)96 * DM); \
  S##b0 = *(const u32x4*)(gb + (koff));                              \
  S##b1 = *(const u32x4*)(gb + (koff) + (size_t)32 * DM);            \
  S##b2 = *(const u32x4*)(gb + (koff) + (size_t)64 * DM);            \
  S##b3 = *(const u32x4*)(gb + (koff) + (size_t)96 * DM);
#define GEMM_LSTORE(S, boff)                                         \
  *(u32x4*)(sA + (boff) + loff) = S##a0;                             \
  *(u32x4*)(sA + (boff) + loff + 32 * 64) = S##a1;                   \
  *(u32x4*)(sA + (boff) + loff + 64 * 64) = S##a2;                   \
  if (MI == 4) *(u32x4*)(sA + (boff) + loff + 96 * 64) = S##a3;      \
  *(u32x4*)(sB + (boff) + loff) = S##b0;                             \
  *(u32x4*)(sB + (boff) + loff + 32 * 64) = S##b1;                   \
  *(u32x4*)(sB + (boff) + loff + 64 * 64) = S##b2;                   \
  *(u32x4*)(sB + (boff) + loff + 96 * 64) = S##b3;
#define GEMM_COMPUTE(cA, cB)                                                                      \
  _Pragma("unroll") for (int ks = 0; ks < 2; ks++) {                                               \
    bf16x8 af[MI], bfr[4];                                                                         \
    const int kc = ks * 4 + (lane >> 4);                                                           \
    _Pragma("unroll") for (int mi = 0; mi < MI; mi++) {                                            \
      const int row = wm * (MI * 16) + mi * 16 + (lane & 15);                                      \
      af[mi] = *(const bf16x8*)((cA) + row * 64 + ((kc ^ (row & 7)) * 8));                         \
    }                                                                                              \
    _Pragma("unroll") for (int ni = 0; ni < 4; ni++) {                                             \
      const int row = wn * 64 + ni * 16 + (lane & 15);                                             \
      bfr[ni] = *(const bf16x8*)((cB) + row * 64 + ((kc ^ (row & 7)) * 8));                        \
    }                                                                                              \
    _Pragma("unroll") for (int mi = 0; mi < MI; mi++)                                              \
      _Pragma("unroll") for (int ni = 0; ni < 4; ni++)                                             \
        acc[mi][ni] = __builtin_amdgcn_mfma_f32_16x16x32_bf16(af[mi], bfr[ni], acc[mi][ni], 0, 0, 0); \
  }
template <int MODE, int MI>
__device__ void gemm_phase(const Params& p, char* smem, int bid, int nb, const bf16_t* __restrict__ A,
                           const bf16_t* __restrict__ Bt, const int N) {
  constexpr int K = DM;
  bf16_t* sA = (bf16_t*)smem;
  bf16_t* sB = sA + 2 * 8192;
  const int tid = opaque_tid(), lane = tid & 63, wave = tid >> 6;
  const int wm = wave >> 1, wn = wave & 1;
  const int ntn = N / 128;
  constexpr int BM = MI * 32;
  const int ntiles = (NTOK / BM) * ntn;
  const int lrow = tid >> 3, lkc = tid & 7;
  const u32x4 z4_ = u32x4{0, 0, 0, 0};
  u32x4 p0a0 = z4_, p0a1 = z4_, p0a2 = z4_, p0a3 = z4_, p0b0 = z4_, p0b1 = z4_, p0b2 = z4_, p0b3 = z4_;
  u32x4 p1a0 = z4_, p1a1 = z4_, p1a2 = z4_, p1a3 = z4_, p1b0 = z4_, p1b1 = z4_, p1b2 = z4_, p1b3 = z4_;
  const int loff = lrow * 64 + ((lkc ^ (lrow & 7)) * 8);
  constexpr int KT = K / 64;
  const bf16_t* ga = A;
  const bf16_t* gb = Bt;
  if (bid < ntiles) {
    ga = A + (size_t)((bid / ntn) * BM + lrow) * K + lkc * 8;
    gb = Bt + (size_t)((bid % ntn) * 128 + lrow) * K + lkc * 8;
    GEMM_GLOAD(p0, 0)
    GEMM_GLOAD(p1, 64)
  }
  for (int t = bid; t < ntiles; t += nb) {
    const int mt = t / ntn, nt = t % ntn;
    const int m0 = mt * BM, n0 = nt * 128;
    f32x4 acc[MI][4];
#pragma unroll
    for (int i = 0; i < MI; i++)
#pragma unroll
      for (int j = 0; j < 4; j++) acc[i][j] = f32x4{0.f, 0.f, 0.f, 0.f};
    GEMM_LSTORE(p0, 0)
    __syncthreads();
#pragma unroll 1
    for (int kt = 0; kt < KT; kt += 2) {
      if (MODE == 1 && kt == KT / 2) {
#pragma unroll
        for (int mi = 0; mi < MI; mi++)
#pragma unroll
          for (int j = 0; j < 4; j++) {
            const int row = m0 + wm * (MI * 16) + mi * 16 + (lane >> 4) * 4 + j;
            const float ra = rsqrtf(p.ssq[row] * (1.0f / 1024.0f) + EPSV);
            const float rl = rsqrtf(p.ssq[NTOK + row] * (1.0f / 1024.0f) + EPSV);
            const float ratio = ra / rl;
#pragma unroll
            for (int ni = 0; ni < 4; ni++) acc[mi][ni][j] *= ratio;
          }
      }
      { const int k2 = min(kt + 2, KT - 1) * 64; GEMM_GLOAD(p0, k2) }
      __builtin_amdgcn_sched_barrier(0);
      GEMM_COMPUTE(sA, sB)
      GEMM_LSTORE(p1, 8192)
      __syncthreads();
      { const int k3 = min(kt + 3, KT - 1) * 64; GEMM_GLOAD(p1, k3) }
      __builtin_amdgcn_sched_barrier(0);
      GEMM_COMPUTE(sA + 8192, sB + 8192)
      GEMM_LSTORE(p0, 0)
      __syncthreads();
    }
    {
      const int tn = t + nb;
      if (tn < ntiles) {
        ga = A + (size_t)((tn / ntn) * BM + lrow) * K + lkc * 8;
        gb = Bt + (size_t)((tn % ntn) * 128 + lrow) * K + lkc * 8;
        GEMM_GLOAD(p0, 0)
        GEMM_GLOAD(p1, 64)
      }
    }
#pragma unroll
    for (int mi = 0; mi < MI; mi++)
#pragma unroll
      for (int j = 0; j < 4; j++) {
        const int row = m0 + wm * (MI * 16) + mi * 16 + (lane >> 4) * 4 + j;
        float rs = 1.0f, sq = 0.f;
        if (MODE == 1) rs = rsqrtf(p.ssq[NTOK + row] * (1.0f / 1024.0f) + EPSV);
        if (MODE == 2) rs = rsqrtf(p.ssq[2 * NTOK + row] * (1.0f / 2048.0f) + EPSV);
#pragma unroll
        for (int ni = 0; ni < 4; ni++) {
          const int col = n0 + wn * 64 + ni * 16 + (lane & 15);
          const float v = acc[mi][ni][j] * rs;
          if (MODE == 0) p.zb[(size_t)row * INW + col] = f2bf(v);
          else if (MODE == 1) {
            const float x1 = xrow(p, row)[col] + v;
            p.out[OFF_Y + (size_t)row * DM + col] = x1;
            p.act2[(size_t)row * DM + col] = f2bf(x1);
            sq += x1 * x1;
          } else p.pq[(size_t)row * DM + col] = f2bf(v);
        }
        if (MODE == 1) {
          sq = row16_sum(sq);
          if ((lane & 15) == 0) atomicAdd(&p.ssq[2 * NTOK + row], sq);
        }
      }
  }
  if (false && MODE != 0) {
    const int rem = ntiles % nb;
    if (rem == 0 || bid >= rem) {
      const int worker = rem ? bid - rem : bid, nworkers = rem ? nb - rem : nb;
      if (MODE == 1) convert_table_fp8(p.peer_u, p.u8, 256.0f, worker, nworkers, p.g_ffn);
      else convert_table_fp8(p.peer_v, p.v8, 16.0f, worker, nworkers, nullptr);
    }
  }
}

__device__ void phase_qkprep(const Params& p, int bid, int nb) {
  const int tid = opaque_tid(), lane = tid & 63, wave = tid >> 6;
  const float gq = p.g_q[lane], gk = p.g_k[lane];
  const float inv = expf(-9.210340371976184f * (float)(lane & 31) * (2.0f / 64.0f));
  for (int tok = bid * 4 + wave; tok < NTOK; tok += nb * 4) {
    const bool prompt = tok < NPROMPT;
    const int b = prompt ? (tok >> 12) : ((tok - NPROMPT) >> 3);
    const int t = prompt ? (tok & 4095) : ((tok - NPROMPT) & 7);
    const float pos = prompt ? (float)t : (float)(8192 + t);
    float sn, cs;
    sincosf(pos * inv, &sn, &cs);
    const bf16_t* zr = p.zb + (size_t)tok * INW;
    float v[20], vv[4], ss[20];
#pragma unroll
    for (int h = 0; h < 20; h++) v[h] = bf2f_(zr[h * 64 + lane]);
#pragma unroll
    for (int kh = 0; kh < 4; kh++) vv[kh] = bf2f_(zr[1280 + kh * 64 + lane]);
#pragma unroll
    for (int h = 0; h < 20; h++) ss[h] = v[h] * v[h];
#pragma unroll
    for (int o = 32; o > 0; o >>= 1)
#pragma unroll
      for (int h = 0; h < 20; h++) ss[h] += __shfl_xor(ss[h], o);
#pragma unroll
    for (int h = 0; h < 20; h++) {
      const float y = v[h] * rsqrtf(ss[h] * (1.0f / 64.0f) + EPSV) * (h < 16 ? gq : gk);
      const float o = __shfl_xor(y, 32);
      const float r = (lane < 32) ? (y * cs - o * sn) : (y * cs + o * sn);
      if (h < 16) {
        p.qb[(size_t)tok * 1024 + h * 64 + lane] = f2bf(r);
      } else {
        const int kh = h - 16;
        p.kb[(size_t)tok * 256 + kh * 64 + lane] = f2bf(r);
        p.vb[(size_t)tok * 256 + kh * 64 + lane] = f2bf(vv[kh]);
        if (prompt) {
          if (t >= 4096 - 128) {
            const size_t o2 = ((size_t)b * 128 + (t - 3968)) * 256 + kh * 64 + lane;
            p.out[OFF_KP + o2] = r;
            p.out[OFF_VP + o2] = vv[kh];
          }
        } else {
          const size_t o2 = ((size_t)b * 128 + 120 + t) * 256 + kh * 64 + lane;
          p.out[OFF_KS + o2] = r;
          p.out[OFF_VS + o2] = vv[kh];
        }
      }
    }
  }
}

#define LRS 68
__device__ void phase_lru_local(const Params& p, char* smem, int bid, int nb) {
  const int tid = opaque_tid(), lane = tid & 63, wave = tid >> 6;
  const int r15 = lane & 15, q4 = lane >> 4;
  char* wb = smem + wave * (2048 + 2 * 16 * LRS * 4);
  bf16_t* xcb = (bf16_t*)wb;
  float* xcf = (float*)(wb + 2048);
  float* ga = xcf + 16 * LRS;
  for (int u = bid * 4 + wave; u < 4096; u += nb * 4) {
    const bool prompt = u < 2048;
    const int n = u & 15;
    const int ch = n * 64 + lane;
    int b, chunk, tok0, T;
    if (prompt) { b = u >> 10; chunk = (u >> 4) & 63; tok0 = b * 4096 + chunk * 64; T = 64; }
    else { b = (u - 2048) >> 4; chunk = 0; tok0 = NPROMPT + b * 8; T = 8; }
    bf16x8 Bf[2][4][2];
#pragma unroll
    for (int g = 0; g < 2; g++)
#pragma unroll
      for (int nt = 0; nt < 4; nt++)
#pragma unroll
        for (int ks = 0; ks < 2; ks++)
          Bf[g][nt][ks] = *(const bf16x8*)(p.wg_t + ((size_t)((g * 16 + n) * 64 + nt * 16 + r15)) * 64 + ks * 32 + q4 * 8);
    float bav[4], bxv[4], spv[4];
#pragma unroll
    for (int nt = 0; nt < 4; nt++) {
      const int e = n * 64 + nt * 16 + r15;
      bav[nt] = p.b_a[e]; bxv[nt] = p.b_x[e];
      spv[nt] = -8.0f * log1pf(expf(-p.lam[e]));
    }
    const float cb = p.conv_b[ch];
    const float cw0 = p.conv_w[ch], cw1 = p.conv_w[1024 + ch], cw2 = p.conv_w[2048 + ch], cw3 = p.conv_w[3072 + ch];
    float xm3 = 0.f, xm2 = 0.f, xm1 = 0.f, h = 0.f, P = 1.f;
    if (!prompt) {
      xm3 = p.state_conv[((size_t)b * 3 + 0) * 1024 + ch];
      xm2 = p.state_conv[((size_t)b * 3 + 1) * 1024 + ch];
      xm1 = p.state_conv[((size_t)b * 3 + 2) * 1024 + ch];
      h = p.state_h[(size_t)b * 1024 + ch];
    } else if (chunk > 0) {
      xm3 = bf2f_(p.zb[(size_t)(tok0 - 3) * INW + 1536 + ch]);
      xm2 = bf2f_(p.zb[(size_t)(tok0 - 2) * INW + 1536 + ch]);
      xm1 = bf2f_(p.zb[(size_t)(tok0 - 1) * INW + 1536 + ch]);
    }
#pragma unroll 1
    for (int t0 = 0; t0 < T; t0 += 16) {
      const int nv = min(16, T - t0);
      float xr[16];
#pragma unroll
      for (int i = 0; i < 16; i++) xr[i] = (i < nv) ? bf2f_(p.zb[(size_t)(tok0 + t0 + i) * INW + 1536 + ch]) : 0.f;
#pragma unroll
      for (int i = 0; i < 16; i++) {
        const float xc = cw0 * xm3 + cw1 * xm2 + cw2 * xm1 + cw3 * xr[i] + cb;
        if (i < nv) { xm3 = xm2; xm2 = xm1; xm1 = xr[i]; }
        xcf[i * LRS + lane] = xc;
        xcb[i * 64 + (((lane >> 3) ^ (i & 7)) * 8) + (lane & 7)] = f2bf(xc);
      }
      __builtin_amdgcn_fence(__ATOMIC_RELEASE, "wavefront");
      __builtin_amdgcn_wave_barrier();
      __builtin_amdgcn_fence(__ATOMIC_ACQUIRE, "wavefront");
      const bf16x8 A0 = *(const bf16x8*)(xcb + r15 * 64 + ((q4 ^ (r15 & 7)) * 8));
      const bf16x8 A1 = *(const bf16x8*)(xcb + r15 * 64 + (((4 + q4) ^ (r15 & 7)) * 8));
#pragma unroll
      for (int nt = 0; nt < 4; nt++) {
        f32x4 aa = f32x4{0.f, 0.f, 0.f, 0.f}, ax = f32x4{0.f, 0.f, 0.f, 0.f};
        aa = __builtin_amdgcn_mfma_f32_16x16x32_bf16(A0, Bf[0][nt][0], aa, 0, 0, 0);
        aa = __builtin_amdgcn_mfma_f32_16x16x32_bf16(A1, Bf[0][nt][1], aa, 0, 0, 0);
        ax = __builtin_amdgcn_mfma_f32_16x16x32_bf16(A0, Bf[1][nt][0], ax, 0, 0, 0);
        ax = __builtin_amdgcn_mfma_f32_16x16x32_bf16(A1, Bf[1][nt][1], ax, 0, 0, 0);
#pragma unroll
        for (int j = 0; j < 4; j++) {
          const int o = (q4 * 4 + j) * LRS + nt * 16 + r15;
          const float r = sigmoidf_(aa[j] + bav[nt]);
          const float ig = sigmoidf_(ax[j] + bxv[nt]);
          const float la = r * spv[nt];
          const float a = __expf(la);
          const float x2 = 2.0f * la;
          const float om = (x2 > -0.02f) ? (-x2 * (1.0f + x2 * (0.5f + x2 * (1.0f / 6.0f)))) : (1.0f - a * a);
          const float uu = sqrtf(om) * ig * xcf[o];
          ga[o] = a;
          xcf[o] = uu;
        }
      }
      __builtin_amdgcn_fence(__ATOMIC_RELEASE, "wavefront");
      __builtin_amdgcn_wave_barrier();
      __builtin_amdgcn_fence(__ATOMIC_ACQUIRE, "wavefront");
#pragma unroll
      for (int i = 0; i < 16; i++) {
        if (i < nv) {
          const float a = ga[i * LRS + lane];
          const float uu = xcf[i * LRS + lane];
          h = a * h + uu;
          P *= a;
          const size_t o = (size_t)(tok0 + t0 + i) * 1024 + ch;
          ((bf16_t*)p.hloc)[o] = f2bf(h);
          ((bf16_t*)p.pc)[o] = f2bf(P);
        }
      }
      __builtin_amdgcn_fence(__ATOMIC_RELEASE, "wavefront");
      __builtin_amdgcn_wave_barrier();
    }
    if (prompt) {
      p.chA[((size_t)b * 64 + chunk) * 1024 + ch] = P;
      p.chU[((size_t)b * 64 + chunk) * 1024 + ch] = h;
    }
  }
}

#define VS 200
template <int NT>
__device__ __forceinline__ void attn_qtile(const bf16_t* sK, const bf16_t* sVt, const bf16_t* qptr, const int i_idx,
                                           const int jmin, const float sink, f32x4 (&o)[4], const int lane) {
  const int r15 = lane & 15, q4 = lane >> 4;
  bf16x8 qf[2];
  qf[0] = *(const bf16x8*)(qptr);
  qf[1] = *(const bf16x8*)(qptr + 32);
  const bf16_t* kb0 = sK + r15 * 64 + ((q4 ^ (r15 & 7)) * 8);
  const bf16_t* kb1 = sK + r15 * 64 + (((4 + q4) ^ (r15 & 7)) * 8);
  f32x4 s[NT];
#pragma unroll
  for (int t = 0; t < NT; t++) {
    s[t] = f32x4{0.f, 0.f, 0.f, 0.f};
    bf16x8 a0 = *(const bf16x8*)(kb0 + t * 1024);
    bf16x8 a1 = *(const bf16x8*)(kb1 + t * 1024);
    s[t] = __builtin_amdgcn_mfma_f32_16x16x32_bf16(a0, qf[0], s[t], 0, 0, 0);
    s[t] = __builtin_amdgcn_mfma_f32_16x16x32_bf16(a1, qf[1], s[t], 0, 0, 0);
    if (t & 1) __builtin_amdgcn_sched_barrier(0);
  }
  float m = sink;
  const int jb = q4 * 4 - i_idx;
#pragma unroll
  for (int t = 0; t < NT; t++)
#pragma unroll
    for (int j = 0; j < 4; j++) {
      const int dj = t * 16 + j + jb;
      const bool valid = (dj > 0) && (dj <= 128) && (dj + i_idx >= jmin);
      float v = valid ? s[t][j] * 0.125f : -1e30f;
      s[t][j] = v;
      m = fmaxf(m, v);
    }
  m = fmaxf(m, __shfl_xor(m, 16));
  m = fmaxf(m, __shfl_xor(m, 32));
  float sum = 0.f;
#pragma unroll
  for (int t = 0; t < NT; t++)
#pragma unroll
    for (int j = 0; j < 4; j++) {
      float e = __expf(s[t][j] - m);
      s[t][j] = e;
      sum += e;
    }
  sum += __shfl_xor(sum, 16);
  sum += __shfl_xor(sum, 32);
  sum += __expf(sink - m);
  const float inv = 1.0f / sum;
  const bf16_t* vbase = sVt + r15 * VS + q4 * 4;
#pragma unroll
  for (int kk = 0; kk < NT / 2; kk++) {
    union { bf16x8 v; unsigned u[4]; } pa;
    pa.u[0] = pack2bf(s[2 * kk][0] * inv, s[2 * kk][1] * inv);
    pa.u[1] = pack2bf(s[2 * kk][2] * inv, s[2 * kk][3] * inv);
    pa.u[2] = pack2bf(s[2 * kk + 1][0] * inv, s[2 * kk + 1][1] * inv);
    pa.u[3] = pack2bf(s[2 * kk + 1][2] * inv, s[2 * kk + 1][3] * inv);
#pragma unroll
    for (int dt = 0; dt < 4; dt++) {
      union { bf16x8 v; uint2 h[2]; } bv;
      bv.h[0] = *(const uint2*)(vbase + dt * 16 * VS + kk * 32);
      bv.h[1] = *(const uint2*)(vbase + dt * 16 * VS + kk * 32 + 16);
      o[dt] = __builtin_amdgcn_mfma_f32_16x16x32_bf16(pa.v, bv.v, o[dt], 0, 0, 0);
    }
    __builtin_amdgcn_sched_barrier(0);
  }
}

__device__ __forceinline__ void kv_to_lds(bf16_t* sK, bf16_t* sVt, int key, int dc, const uint4& kv, const uint4& vv) {
  *(uint4*)(sK + key * 64 + ((dc ^ (key & 7)) * 8)) = kv;
  bf16_t* vp = sVt + (dc * 8) * VS + key;
  vp[0 * VS] = (bf16_t)(vv.x & 0xFFFF); vp[1 * VS] = (bf16_t)(vv.x >> 16);
  vp[2 * VS] = (bf16_t)(vv.y & 0xFFFF); vp[3 * VS] = (bf16_t)(vv.y >> 16);
  vp[4 * VS] = (bf16_t)(vv.z & 0xFFFF); vp[5 * VS] = (bf16_t)(vv.z >> 16);
  vp[6 * VS] = (bf16_t)(vv.w & 0xFFFF); vp[7 * VS] = (bf16_t)(vv.w >> 16);
}

__device__ void phase_attn(const Params& p, char* smem, int bid, int nb) {
  const int tid = opaque_tid(), lane = tid & 63, wave = tid >> 6;
  bf16_t* sK = (bf16_t*)smem;
  bf16_t* sVt = sK + 192 * 64;
  for (int unit = bid; unit < 512 + 512; unit += nb) {
    __syncthreads();
    if (unit < 512) {
      const int kvh = unit & 3, n = (unit >> 2) & 63, b = unit >> 8;
      if (tid < 192) {
#pragma unroll 2
        for (int i = 0; i < 8; i++) {
          const int key = tid, dc = i;
          const int tk = n * 64 - 128 + key;
          uint4 kv = uint4{0, 0, 0, 0}, vv = uint4{0, 0, 0, 0};
          if (tk >= 0) {
            kv = *(const uint4*)(p.kb + (size_t)(b * 4096 + tk) * 256 + kvh * 64 + dc * 8);
            vv = *(const uint4*)(p.vb + (size_t)(b * 4096 + tk) * 256 + kvh * 64 + dc * 8);
          }
          kv_to_lds(sK, sVt, key, dc, kv, vv);
        }
      }
      __syncthreads();
      const int hq = kvh * 4 + wave;
      const float sink = p.sinks[hq];
      const int jmin = 128 - n * 64;
#pragma unroll 1
      for (int qt = 0; qt < 4; qt++) {
        const int i_idx = qt * 16 + (lane & 15);
        const int tokq = b * 4096 + n * 64 + i_idx;
        f32x4 o[4];
#pragma unroll
        for (int dt = 0; dt < 4; dt++) o[dt] = f32x4{0.f, 0.f, 0.f, 0.f};
        attn_qtile<12>(sK, sVt, p.qb + (size_t)tokq * 1024 + hq * 64 + (lane >> 4) * 8, i_idx, jmin, sink, o, lane);
        const int tokbase = b * 4096 + n * 64 + qt * 16;
        bf16_t* op = p.act + (size_t)(tokbase + (lane >> 4) * 4) * DM + hq * 64 + (lane & 15);
#pragma unroll
        for (int j = 0; j < 4; j++) {
          float sq = 0.f;
#pragma unroll
          for (int dt = 0; dt < 4; dt++) { op[(size_t)j * DM + dt * 16] = f2bf(o[dt][j]); sq += o[dt][j] * o[dt][j]; }
          sq = row16_sum(sq);
          if ((lane & 15) == 0) atomicAdd(&p.ssq[tokbase + (lane >> 4) * 4 + j], sq);
        }
      }
    } else {
      const int us = unit - 512;
      const int kvh = us & 3, b = us >> 2;
#pragma unroll 1
      for (int i = 0; i < 5; i++) {
        const int id = tid + i * 256;
        const int key = id % 160, dc = id / 160;
        uint4 kv = uint4{0, 0, 0, 0}, vv = uint4{0, 0, 0, 0};
        if (key < 128) {
          const float* ck = p.cache_k + (((size_t)b * 128 + key) * 4 + kvh) * 64 + dc * 8;
          const float* cv = p.cache_v + (((size_t)b * 128 + key) * 4 + kvh) * 64 + dc * 8;
          float4 a0 = *(const float4*)ck, a1 = *(const float4*)(ck + 4);
          float4 b0 = *(const float4*)cv, b1 = *(const float4*)(cv + 4);
          kv.x = pack2bf(a0.x, a0.y); kv.y = pack2bf(a0.z, a0.w); kv.z = pack2bf(a1.x, a1.y); kv.w = pack2bf(a1.z, a1.w);
          vv.x = pack2bf(b0.x, b0.y); vv.y = pack2bf(b0.z, b0.w); vv.z = pack2bf(b1.x, b1.y); vv.w = pack2bf(b1.z, b1.w);
        } else if (key < 136) {
          kv = *(const uint4*)(p.kb + (size_t)(NPROMPT + b * 8 + key - 128) * 256 + kvh * 64 + dc * 8);
          vv = *(const uint4*)(p.vb + (size_t)(NPROMPT + b * 8 + key - 128) * 256 + kvh * 64 + dc * 8);
        }
        kv_to_lds(sK, sVt, key, dc, kv, vv);
      }
      __syncthreads();
      if (wave < 2) {
        const int r = lane & 15;
        const int hq = kvh * 4 + wave * 2 + (r >> 3);
        const int s_idx = r & 7;
        const int tokq = NPROMPT + b * 8 + s_idx;
        f32x4 o[4];
#pragma unroll
        for (int dt = 0; dt < 4; dt++) o[dt] = f32x4{0.f, 0.f, 0.f, 0.f};
        attn_qtile<10>(sK, sVt, p.qb + (size_t)tokq * 1024 + hq * 64 + (lane >> 4) * 8, s_idx, 0, p.sinks[hq], o, lane);
#pragma unroll
        for (int j = 0; j < 4; j++) {
          const int rr = (lane >> 4) * 4 + j;
          const int hq2 = kvh * 4 + wave * 2 + (rr >> 3);
          bf16_t* op = p.act + (size_t)(NPROMPT + b * 8 + (rr & 7)) * DM + hq2 * 64 + (lane & 15);
          float sq = 0.f;
#pragma unroll
          for (int dt = 0; dt < 4; dt++) { op[dt * 16] = f2bf(o[dt][j]); sq += o[dt][j] * o[dt][j]; }
          sq = row16_sum(sq);
          if ((lane & 15) == 0) atomicAdd(&p.ssq[NPROMPT + b * 8 + (rr & 7)], sq);
        }
      }
    }
  }
}

__device__ void phase_lru_apply(const Params& p, int bid, int nb) {
  const int tid = opaque_tid(), lane = tid & 63, wave = tid >> 6;
  for (int u = bid * 4 + wave; u < 4096; u += nb * 4) {
    const bool prompt = u < 2048;
    const int n = u & 15;
    const int ch = n * 64 + lane;
    int b, chunk, tok0, T;
    if (prompt) { b = u >> 10; chunk = (u >> 4) & 63; tok0 = b * 4096 + chunk * 64; T = 64; }
    else { b = (u - 2048) >> 4; chunk = 0; tok0 = NPROMPT + b * 8; T = 8; }
    float hin = 0.f;
    if (prompt) {
#pragma unroll 1
      for (int k0 = 0; k0 < chunk; k0 += 16) {
        float av[16], uv[16];
#pragma unroll
        for (int k = 0; k < 16; k++) {
          const bool ok = (k0 + k) < chunk;
          const size_t o = ((size_t)b * 64 + (ok ? k0 + k : 0)) * 1024 + ch;
          av[k] = p.chA[o]; uv[k] = p.chU[o];
          if (!ok) { av[k] = 1.f; uv[k] = 0.f; }
        }
#pragma unroll
        for (int k = 0; k < 16; k++) hin = av[k] * hin + uv[k];
      }
    }
    float h = 0.f;
#pragma unroll 8
    for (int t = 0; t < T; t++) {
      const size_t tok = tok0 + t;
      h = bf2f_(((const bf16_t*)p.hloc)[tok * 1024 + ch]) + bf2f_(((const bf16_t*)p.pc)[tok * 1024 + ch]) * hin;
      float yg = bf2f_(p.zb[tok * INW + 2560 + ch]);
      const float yv = h * gelu_tanh(yg);
      p.act[tok * DM + 1024 + ch] = f2bf(yv);
      const float sq = wave_sum(yv * yv);
      if (lane == 0) atomicAdd(&p.ssq[NTOK + tok], sq);
    }
    if (prompt) {
      if (chunk == 63) {
        p.out[OFF_HP + (size_t)b * 1024 + ch] = h;
#pragma unroll
        for (int j = 0; j < 3; j++)
          p.out[OFF_CP + ((size_t)b * 3 + j) * 1024 + ch] = bf2f_(p.zb[(size_t)(b * 4096 + 4093 + j) * INW + 1536 + ch]);
      }
    } else {
      p.out[OFF_HS + (size_t)b * 1024 + ch] = h;
#pragma unroll
      for (int j = 0; j < 3; j++)
        p.out[OFF_CS + ((size_t)b * 3 + j) * 1024 + ch] = bf2f_(p.zb[(size_t)(NPROMPT + b * 8 + 5 + j) * INW + 1536 + ch]);
    }
  }
}

__device__ __forceinline__ int ordf(float f) { int b = __float_as_int(f); return b ^ ((b >> 31) & 0x7FFFFFFF); }
__device__ __forceinline__ float unordf(int o) { return __int_as_float(o ^ ((o >> 31) & 0x7FFFFFFF)); }
template <int CTRL>
__device__ __forceinline__ int dppi(int v) { return __builtin_amdgcn_update_dpp(0, v, CTRL, 0xF, 0xF, true); }
__device__ __forceinline__ int row16_allmax(int m) {
  m = max(m, dppi<0xB1>(m));
  m = max(m, dppi<0x4E>(m));
  m = max(m, dppi<0x141>(m));
  m = max(m, dppi<0x140>(m));
  return m;
}
__device__ __forceinline__ int quad_allmax(int m) {
  m = max(m, dppi<0xB1>(m));
  m = max(m, dppi<0x4E>(m));
  return m;
}

__device__ void phase_peer_select(const Params& p, char* smem, int bid, int nb) {
  const int tid = opaque_tid(), lane = tid & 63, wave = tid >> 6;
  int* tab = (int*)smem;
  int* st = tab + 64 + wave * 512;
  if (tid < 64) {
    int e = -1, cnt = 0;
    for (int i = 0; i < 16; i++) {
      int nn = 16 / (i + 1);
      if (tid >= cnt && tid < cnt + nn) e = i | ((tid - cnt) << 4);
      cnt += nn;
    }
    tab[tid] = e;
  }
  __syncthreads();
  const int r15 = lane & 15, q4 = lane >> 4;
  const int hh = bid & 7;
  for (int tt = (bid >> 3) * 4 + wave; tt < 576; tt += (nb >> 3) * 4) {
#pragma unroll 1
    for (int c = 0; c < 2; c++) {
      f32x4 acc[8];
#pragma unroll
      for (int kt = 0; kt < 8; kt++) acc[kt] = f32x4{0.f, 0.f, 0.f, 0.f};
      const bf16_t* arow = p.pq + (size_t)(tt * 16 + r15) * DM + hh * 256 + c * 128 + q4 * 8;
      const bf16_t* brow = p.sk_bf + ((size_t)((hh * 2 + c) * 128 + r15)) * 128 + q4 * 8;
      bf16x8 af4[4];
#pragma unroll
      for (int ks = 0; ks < 4; ks++) af4[ks] = *(const bf16x8*)(arow + ks * 32);
      bf16x8 bq0[8], bq1[8];
#pragma unroll
      for (int kt = 0; kt < 8; kt++) bq0[kt] = *(const bf16x8*)(brow + kt * 16 * 128);
#pragma unroll
      for (int kt = 0; kt < 8; kt++) bq1[kt] = *(const bf16x8*)(brow + kt * 16 * 128 + 32);
      __builtin_amdgcn_sched_barrier(0);
#pragma unroll
      for (int kt = 0; kt < 8; kt++) acc[kt] = __builtin_amdgcn_mfma_f32_16x16x32_bf16(af4[0], bq0[kt], acc[kt], 0, 0, 0);
#pragma unroll
      for (int kt = 0; kt < 8; kt++) bq0[kt] = *(const bf16x8*)(brow + kt * 16 * 128 + 64);
      __builtin_amdgcn_sched_barrier(0);
#pragma unroll
      for (int kt = 0; kt < 8; kt++) acc[kt] = __builtin_amdgcn_mfma_f32_16x16x32_bf16(af4[1], bq1[kt], acc[kt], 0, 0, 0);
#pragma unroll
      for (int kt = 0; kt < 8; kt++) bq1[kt] = *(const bf16x8*)(brow + kt * 16 * 128 + 96);
      __builtin_amdgcn_sched_barrier(0);
#pragma unroll
      for (int kt = 0; kt < 8; kt++) acc[kt] = __builtin_amdgcn_mfma_f32_16x16x32_bf16(af4[2], bq0[kt], acc[kt], 0, 0, 0);
#pragma unroll
      for (int kt = 0; kt < 8; kt++) acc[kt] = __builtin_amdgcn_mfma_f32_16x16x32_bf16(af4[3], bq1[kt], acc[kt], 0, 0, 0);
      int key[8][4];
#pragma unroll
      for (int kt = 0; kt < 8; kt++)
#pragma unroll
        for (int j = 0; j < 4; j++) key[kt][j] = (ordf(acc[kt][j]) & ~127) | (127 - (kt * 16 + r15));
#define CE_(a, b) { const int hi_ = max(key[a][j], key[b][j]); const int lo_ = min(key[a][j], key[b][j]); key[a][j] = hi_; key[b][j] = lo_; }
#pragma unroll
      for (int j = 0; j < 4; j++) {
        CE_(0, 1) CE_(2, 3) CE_(4, 5) CE_(6, 7)
        CE_(0, 2) CE_(1, 3) CE_(4, 6) CE_(5, 7)
        CE_(1, 2) CE_(5, 6)
        CE_(0, 4) CE_(1, 5) CE_(2, 6) CE_(3, 7)
        CE_(2, 4) CE_(3, 5)
        CE_(1, 2) CE_(3, 4) CE_(5, 6)
      }
#undef CE_
      int top[4] = {INT32_MIN, INT32_MIN, INT32_MIN, INT32_MIN};
#pragma unroll 1
      for (int it = 0; it < 16; it++) {
#pragma unroll
        for (int j = 0; j < 4; j++) {
          const int m = row16_allmax(key[0][j]);
          const bool own = (key[0][j] == m);
#pragma unroll
          for (int kt = 0; kt < 7; kt++) key[kt][j] = own ? key[kt + 1][j] : key[kt][j];
          key[7][j] = own ? INT32_MIN : key[7][j];
          top[j] = (r15 == it) ? m : top[j];
        }
      }
#pragma unroll
      for (int j = 0; j < 4; j++) st[c * 256 + (q4 * 4 + j) * 16 + r15] = top[j];
    }
    __builtin_amdgcn_fence(__ATOMIC_RELEASE, "wavefront");
    __builtin_amdgcn_wave_barrier();
    __builtin_amdgcn_fence(__ATOMIC_ACQUIRE, "wavefront");
    const int tl = lane >> 2, sub = lane & 3;
    int ck[13];
#pragma unroll
    for (int q = 0; q < 13; q++) {
      const int pidx = sub + 4 * q;
      const int e = tab[pidx];
      int kv = INT32_MIN;
      if (e >= 0) {
        int ka = st[tl * 16 + (e & 15)];
        int kb2 = st[256 + tl * 16 + (e >> 4)];
        float s = unordf(ka & ~127) + unordf(kb2 & ~127);
        kv = (ordf(s) & ~63) | pidx;
      }
      ck[q] = kv;
    }
    int mine[4] = {0, 0, 0, 0};
    int m0 = 0;
#pragma unroll
    for (int r = 0; r < 16; r++) {
      int m = ck[0];
#pragma unroll
      for (int q = 1; q < 13; q++) m = max(m, ck[q]);
      m = quad_allmax(m);
#pragma unroll
      for (int q = 0; q < 13; q++) ck[q] = (ck[q] == m) ? INT32_MIN : ck[q];
      if (r == 0) m0 = m;
      mine[r >> 2] = (sub == (r & 3)) ? m : mine[r >> 2];
    }
    const float mx = unordf(m0 & ~63);
    float ev[4];
    float sum = 0.f;
#pragma unroll
    for (int k = 0; k < 4; k++) { ev[k] = __expf(unordf(mine[k] & ~63) - mx); sum += ev[k]; }
    sum += __shfl_xor(sum, 1);
    sum += __shfl_xor(sum, 2);
    const float inv = 1.0f / sum;
#pragma unroll
    for (int k = 0; k < 4; k++) {
      const int e = tab[mine[k] & 63];
      const int ia = 127 - (st[tl * 16 + (e & 15)] & 127);
      const int ib = 127 - (st[256 + tl * 16 + (e >> 4)] & 127);
      const size_t o = (size_t)(tt * 16 + tl) * 128 + hh * 16 + k * 4 + sub;
      p.sel_eid[o] = ia * 128 + ib;
      p.sel_g[o] = ev[k] * inv;
    }
    __builtin_amdgcn_fence(__ATOMIC_RELEASE, "wavefront");
    __builtin_amdgcn_wave_barrier();
  }
}

struct XInfo { int wx, nwx, popidx, npop; };
__device__ __forceinline__ float dppf_add8(float v) {
  v += __int_as_float(__builtin_amdgcn_update_dpp(0, __float_as_int(v), 0xB1, 0xF, 0xF, false));
  v += __int_as_float(__builtin_amdgcn_update_dpp(0, __float_as_int(v), 0x4E, 0xF, 0xF, false));
  v += __int_as_float(__builtin_amdgcn_update_dpp(0, __float_as_int(v), 0x141, 0xF, 0xF, false));
  return v;
}
__device__ __forceinline__ float dot16_fp8v(const u32x4& r, const f32x2* h2) {
  f32x2 acc = f32x2{0.f, 0.f};
#pragma unroll
  for (int q = 0; q < 4; q++) {
    f32x2 lo = __builtin_amdgcn_cvt_pk_f32_fp8((int)r[q], false);
    f32x2 hi = __builtin_amdgcn_cvt_pk_f32_fp8((int)r[q], true);
    acc = lo * h2[q * 2] + acc;
    acc = hi * h2[q * 2 + 1] + acc;
  }
  return acc[0] + acc[1];
}
__device__ __forceinline__ void axpy16_fp8v(float w, const u32x4& r, f32x2* f2) {
  const f32x2 w2 = f32x2{w, w};
#pragma unroll
  for (int q = 0; q < 4; q++) {
    f32x2 lo = __builtin_amdgcn_cvt_pk_f32_fp8((int)r[q], false);
    f32x2 hi = __builtin_amdgcn_cvt_pk_f32_fp8((int)r[q], true);
    f2[q * 2] = w2 * lo + f2[q * 2];
    f2[q * 2 + 1] = w2 * hi + f2[q * 2 + 1];
  }
}
#define NITEM (NTOK * 128)
__device__ __forceinline__ void phase_peer_u(const Params& p, const XInfo& xi) {
  const int tid = opaque_tid(), lane = tid & 63, j8 = lane & 7, g = lane >> 3;
  int nown = 0;
  for (int ss = 0; ss < 16; ss++) nown += (((ss >> 1) % xi.npop) == xi.popidx) ? 1 : 0;
  const int nitems = nown * (NTOK / 8);
#pragma unroll 1
  for (int idx = xi.wx; idx < nitems; idx += xi.nwx) {
    const int ord = idx / (NTOK / 8), B = idx % (NTOK / 8);
    int ss = 0;
    { int c = 0; for (int q = 0; q < 16; q++) if (((q >> 1) % xi.npop) == xi.popidx) { if (c == ord) ss = q; c++; } }
    const unsigned char* ub = p.u8 + ss * 128 + j8 * 16;
    bf16_t* pdst = (bf16_t*)p.pd + (size_t)ss * NITEM;
    {
      const int tok = B * 8 + g;
      const bool valid = true;
      f32x2 h2[8];
      {
        const bf16_t* hrow = p.act2 + (size_t)tok * DM + ss * 128 + j8 * 16;
        u32x4 r0 = *(const u32x4*)(hrow), r1 = *(const u32x4*)(hrow + 8);
#pragma unroll
        for (int q = 0; q < 4; q++) {
          h2[q] = f32x2{bflo(r0[q]), bfhi(r0[q])};
          h2[4 + q] = f32x2{bflo(r1[q]), bfhi(r1[q])};
        }
      }
      const int* ep = p.sel_eid + (size_t)tok * 128;
      i32x8 e;
#pragma unroll
      for (int k = 0; k < 8; k++) e[k] = ep[k];
#pragma unroll 1
      for (int it0 = 0; it0 < 128; it0 += 8) {
        u32x4 r[8];
#pragma unroll
        for (int k = 0; k < 8; k++) r[k] = *(const u32x4*)(ub + (size_t)e[k] * DM);
        const int itn = (it0 + 8) & 127;
#pragma unroll
        for (int k = 0; k < 8; k++) e[k] = ep[itn + k];
        float d[8];
#pragma unroll
        for (int k = 0; k < 8; k++) d[k] = dppf_add8(dot16_fp8v(r[k], h2));
        float o = d[0];
#pragma unroll
        for (int k = 1; k < 8; k++) o = (j8 == k) ? d[k] : o;
        if (valid) pdst[(size_t)tok * 128 + it0 + j8] = f2bf(o);
      }
    }
  }
}
__device__ void phase_peer_w(const Params& p, int bid, int nb) {
  const int tid = opaque_tid();
  for (int i = bid * 256 + tid; i < NITEM; i += nb * 256) {
    float sacc = 0.f;
#pragma unroll
    for (int ss = 0; ss < 16; ss++) sacc += bf2f_(((const bf16_t*)p.pd)[(size_t)ss * NITEM + i]);
    const float rf = rsqrtf(p.ssq[2 * NTOK + (i >> 7)] * (1.0f / 2048.0f) + EPSV);
    p.sel_g[i] = gelu_tanh(sacc * rf * (1.0f / 256.0f)) * p.sel_g[i] * (1.0f / 16.0f);
  }
}
__device__ __forceinline__ void phase_peer_v(const Params& p, const XInfo& xi) {
  const int tid = opaque_tid(), lane = tid & 63, j8 = lane & 7, g = lane >> 3;
  int nown = 0;
  for (int ss = 0; ss < 16; ss++) nown += (((ss >> 1) % xi.npop) == xi.popidx) ? 1 : 0;
  const int nitems = nown * (NTOK / 8);
#pragma unroll 1
  for (int idx = xi.wx; idx < nitems; idx += xi.nwx) {
    const int ord = idx / (NTOK / 8), B = idx % (NTOK / 8);
    int ss = 0;
    { int c = 0; for (int q = 0; q < 16; q++) if (((q >> 1) % xi.npop) == xi.popidx) { if (c == ord) ss = q; c++; } }
    const unsigned char* vb8 = p.v8 + ss * 128 + j8 * 16;
    {
      const int tok = B * 8 + g;
      const bool valid = true;
      f32x2 f2[8];
#pragma unroll
      for (int q = 0; q < 8; q++) f2[q] = f32x2{0.f, 0.f};
      const int* ep = p.sel_eid + (size_t)tok * 128;
      const float* wp = p.sel_g + (size_t)tok * 128;
      i32x8 e; f32x8 w;
#pragma unroll
      for (int k = 0; k < 8; k++) { e[k] = ep[k]; w[k] = wp[k]; }
#pragma unroll 1
      for (int it0 = 0; it0 < 128; it0 += 8) {
        u32x4 r[8]; float wc[8];
#pragma unroll
        for (int k = 0; k < 8; k++) { r[k] = *(const u32x4*)(vb8 + (size_t)e[k] * DM); wc[k] = w[k]; }
        const int itn = (it0 + 8) & 127;
#pragma unroll
        for (int k = 0; k < 8; k++) { e[k] = ep[itn + k]; w[k] = wp[itn + k]; }
#pragma unroll
        for (int k = 0; k < 8; k++) axpy16_fp8v(wc[k], r[k], f2);
      }
      if (valid) {
        float* orow = p.out + OFF_Y + (size_t)tok * DM + ss * 128 + j8 * 16;
#pragma unroll
        for (int q = 0; q < 4; q++) {
          float4 a = *(float4*)(orow + q * 4);
          a.x += f2[q * 2][0]; a.y += f2[q * 2][1]; a.z += f2[q * 2 + 1][0]; a.w += f2[q * 2 + 1][1];
          *(float4*)(orow + q * 4) = a;
        }
      }
    }
  }
}

#define XB_TMO      128
#define XB_XCNT(j)  (256  + 64 * (j))
#define XB_XSUB(j)  (1280 + 64 * (j))
#define XB_XGEN(j)  (2304 + 64 * (j))
#define XB_TOP      3328
#define XB_TOPGEN   3392
#define XCD_BAR_WORDS 3456
#define XB_SPIN_CAP (1u << 22)
#define LAS __attribute__((address_space(3)))
__device__ __forceinline__ unsigned xb_ld(unsigned* p)              { return __hip_atomic_load(p, __ATOMIC_RELAXED, __HIP_MEMORY_SCOPE_AGENT); }
__device__ __forceinline__ unsigned xb_add(unsigned* p, unsigned v) { return __hip_atomic_fetch_add(p, v, __ATOMIC_RELAXED, __HIP_MEMORY_SCOPE_AGENT); }
__device__ __forceinline__ unsigned xb_xcc_id() { return (unsigned)__builtin_amdgcn_s_getreg((3 << 11) | 20) & 0xFu; }
#define XB_SPIN(cond, bar) do { unsigned _sp = 0; while (cond) { __builtin_amdgcn_s_sleep(24); \
    if ((++_sp & 255u) == 0u) { if (xb_ld(&(bar)[XB_TMO])) break; if (_sp > XB_SPIN_CAP) { atomicAdd(&(bar)[XB_TMO], 1u); break; } } } } while (0)
struct XcdBarrier { unsigned* bar; unsigned x; unsigned nloc, nx; };
__device__ __forceinline__ XcdBarrier xcd_barrier_post(unsigned* bar) {
  XcdBarrier b; b.bar = bar; b.x = xb_xcc_id(); b.nloc = 0u; b.nx = 0u;
  if (threadIdx.x == 0) (void)xb_add(&bar[XB_XCNT(b.x)], 1u);
  return b;
}
__device__ __forceinline__ void xcd_barrier_complete(unsigned* bar, unsigned x, unsigned& nloc, unsigned& nx) {
  const unsigned G = gridDim.x * gridDim.y * gridDim.z;
  unsigned sum, cnt, mine, sp = 0u;
  for (;;) {
    sum = 0u; cnt = 0u; mine = 0u;
#pragma unroll
    for (unsigned j = 0; j < 16; ++j) { const unsigned c = xb_ld(&bar[XB_XCNT(j)]); sum += c; cnt += (c > 0u) ? 1u : 0u; mine = (j == x) ? c : mine; }
    if (sum == G) break;
    __builtin_amdgcn_s_sleep(1);
    if ((++sp & 255u) == 0u) { if (xb_ld(&bar[XB_TMO])) break; if (sp > XB_SPIN_CAP) { atomicAdd(&bar[XB_TMO], 1u); break; } }
  }
  nloc = mine > 0u ? mine : 1u; nx = cnt > 0u ? cnt : 1u;
}
__device__ __forceinline__ void xcd_barrier(XcdBarrier& b) {
  asm volatile("s_waitcnt vmcnt(0)" ::: "memory");
  __syncthreads();
  if (threadIdx.x == 0) {
    unsigned* bar = b.bar;
    __builtin_amdgcn_s_waitcnt(0);
    unsigned nloc = b.nloc, nx = b.nx;
    if (nloc == 0u) { xcd_barrier_complete(bar, b.x, nloc, nx); b.nloc = nloc; b.nx = nx; }
    const unsigned old = xb_add(&bar[XB_XSUB(b.x)], 1u);
    const unsigned gen = old / nloc;
    if (old + 1u == (gen + 1u) * nloc) {
      __builtin_amdgcn_fence(__ATOMIC_RELEASE, "agent");
      asm volatile("s_waitcnt vmcnt(0)" ::: "memory");
      const unsigned og = xb_add(&bar[XB_TOP], 1u);
      const unsigned tg = og / nx;
      if (og + 1u == (tg + 1u) * nx) xb_add(&bar[XB_TOPGEN], 1u);
      else XB_SPIN(xb_ld(&bar[XB_TOPGEN]) == tg, bar);
      __builtin_amdgcn_fence(__ATOMIC_ACQUIRE, "agent");
      xb_add(&bar[XB_XGEN(b.x)], 1u);
      asm volatile("s_waitcnt vmcnt(0)" ::: "memory");
    } else {
      XB_SPIN(xb_ld(&bar[XB_XGEN(b.x)]) == gen, bar);
      __builtin_amdgcn_fence(__ATOMIC_ACQUIRE, "agent");
      asm volatile("s_waitcnt vmcnt(0)" ::: "memory");
    }
  }
  __syncthreads();
}

#define NPHASE 10
__device__ __forceinline__ void run_phase(const Params& p, char* smem, int ph, int bid, int nb, const XInfo& xi, const int role) {
  switch (ph) {
    case 0: phase_convert(p, smem, bid, nb); break;
    case 1: gemm_phase<0, 4>(p, smem, bid, nb, p.act, p.w_in_t, INW); break;
    case 2: phase_qkprep(p, bid, nb); phase_lru_local(p, smem, bid, nb); break;
    case 3: phase_attn(p, smem, bid, nb); phase_lru_apply(p, bid, nb); break;
    case 4: gemm_phase<1, 3>(p, smem, bid, nb, p.act, p.w_out_t, DM); break;
    case 5: gemm_phase<2, 3>(p, smem, bid, nb, p.act2, p.w_pq_t, DM); break;
    case 6:
      if (role == 0) {
        convert_table_fp8(p.peer_u, p.u8, 256.0f, bid, nb, p.g_ffn);
        convert_table_fp8(p.peer_v, p.v8, 16.0f, bid, nb, nullptr);
        copy_cache_rows(p, bid, nb);
        phase_peer_select(p, smem, bid, nb);
      } else {
        phase_peer_select(p, smem, bid, nb);
        convert_table_fp8(p.peer_u, p.u8, 256.0f, bid, nb, p.g_ffn);
        convert_table_fp8(p.peer_v, p.v8, 16.0f, bid, nb, nullptr);
        copy_cache_rows(p, bid, nb);
      }
      break;
    case 7: phase_peer_u(p, xi); break;
    case 8: phase_peer_w(p, bid, nb); break;
    case 9: phase_peer_v(p, xi); break;
  }
}

#if ONE_LAUNCH
__global__ void __launch_bounds__(256, 2) k_mega(Params p) {
  __shared__ __attribute__((aligned(16))) char smem[65536];
  __shared__ int s_rank[4];
  XcdBarrier xb; xb.bar = p.bar; xb.x = xb_xcc_id(); xb.nloc = 0u; xb.nx = 0u;
  if (threadIdx.x == 0) {
    s_rank[0] = (int)xb_add(&p.bar[XB_XCNT(xb.x)], 1u);
    const unsigned hwid = (unsigned)__builtin_amdgcn_s_getreg((31 << 11) | 4);
    const unsigned slot = (hwid >> 8) & 0xFFu;
    s_rank[1] = (int)(xb_add(&p.bar[XCD_BAR_WORDS + xb.x * 256 + slot], 1u) & 1u);
  }
  __syncthreads();
  const int rank = s_rank[0];
  const int role = (blockIdx.x >= gridDim.x / 2) ? 1 : 0;
  XInfo xi{0, 0, 0, 1};
#pragma unroll 1
  for (int ph = 0; ph < NPHASE; ph++) {
    if (ph == 7) {
      int npop = 0, popidx = 0, nloc = 1;
      for (int j = 0; j < 16; j++) {
        const int c = (int)xb_ld(&p.bar[XB_XCNT(j)]);
        if (c > 0) { if (j == (int)xb.x) { popidx = npop; nloc = c; } npop++; }
      }
      xi.wx = rank * 4 + (threadIdx.x >> 6); xi.nwx = nloc * 4; xi.popidx = popidx; xi.npop = npop;
    }
    run_phase(p, smem, ph, blockIdx.x, gridDim.x, xi, role);
    if (ph + 1 < NPHASE) xcd_barrier(xb);
  }
}
#endif

extern "C" void kernel_launch(void* const* d_in, const int* in_sizes, int n_in, void* d_out, int out_size, void* d_ws,
                              size_t ws_size, hipStream_t stream) {
  Params p{};
  const float* const* in = (const float* const*)d_in;
  p.x_prompt = in[0]; p.x_sample = in[1]; p.cache_k = in[2]; p.cache_v = in[3]; p.state_conv = in[4]; p.state_h = in[5];
  p.g_mix = in[6]; p.w_in = in[7]; p.g_q = in[8]; p.g_k = in[9]; p.sinks = in[10]; p.conv_w = in[11]; p.conv_b = in[12];
  p.w_a = in[13]; p.b_a = in[14]; p.w_x = in[15]; p.b_x = in[16]; p.lam = in[17]; p.g_ao = in[18]; p.g_lo = in[19];
  p.w_out = in[20]; p.g_ffn = in[21]; p.w_pq = in[22]; p.sub_keys = in[23]; p.peer_u = in[24]; p.peer_v = in[25];
  p.out = (float*)d_out;
  char* w = (char*)d_ws;
  size_t off = 0;
  auto take = [&](size_t bytes) { char* r = w + off; off += (bytes + 255) & ~(size_t)255; return r; };
  p.w_in_t = (bf16_t*)take((size_t)INW * DM * 2);
  p.w_out_t = (bf16_t*)take((size_t)DM * DM * 2);
  p.w_pq_t = (bf16_t*)take((size_t)DM * DM * 2);
  p.sk_bf = (bf16_t*)take((size_t)262144 * 2);
  p.wg_t = (bf16_t*)take((size_t)131072 * 2);
  p.u8 = (unsigned char*)take((size_t)16384 * DM);
  p.v8 = (unsigned char*)take((size_t)16384 * DM);
  p.act = (bf16_t*)take((size_t)NTOK * DM * 2);
  p.z = (float*)take((size_t)NTOK * INW * 4);
  p.zb = (bf16_t*)p.z;
  p.qb = (bf16_t*)take((size_t)NTOK * 1024 * 2);
  p.kb = (bf16_t*)take((size_t)NTOK * 256 * 2);
  p.vb = (bf16_t*)take((size_t)NTOK * 256 * 2);
  p.hloc = (float*)take((size_t)NTOK * 1024 * 4);
  p.pc = (float*)take((size_t)NTOK * 1024 * 4);
  p.chA = (float*)take((size_t)2 * 64 * 1024 * 4);
  p.chU = (float*)take((size_t)2 * 64 * 1024 * 4);
  p.mixraw = (float*)take((size_t)NTOK * DM * 4);
  p.act2 = (bf16_t*)p.mixraw;
  p.ssq = (float*)take((size_t)3 * NTOK * 4);
  p.bar = (unsigned*)take((size_t)(XCD_BAR_WORDS + 16 * 256) * 4);
  p.pd = p.hloc;
  p.pq = (bf16_t*)p.z;
  p.sel_eid = (int*)((char*)p.z + (size_t)NTOK * DM * 2);
  p.sel_g = (float*)((char*)p.z + (size_t)NTOK * DM * 2 + (size_t)NTOK * 128 * 4);
  if (off > ws_size) { fprintf(stderr, "workspace too small: need %zu have %zu\n", off, ws_size); return; }

  static int grid_blocks = 0;
  if (!grid_blocks) {
    int dev = 0, cus = 0, per_cu = 0;
    (void)hipGetDevice(&dev);
    (void)hipDeviceGetAttribute(&cus, hipDeviceAttributeMultiprocessorCount, dev);
#if ONE_LAUNCH
    (void)hipOccupancyMaxActiveBlocksPerMultiprocessor(&per_cu, k_mega, 256, 0);
#endif
    if (per_cu > 2) per_cu = 2;
    if (per_cu < 1) per_cu = 1;
    grid_blocks = cus * per_cu;
  }
#if ONE_LAUNCH
  (void)hipMemsetAsync(p.bar, 0, (size_t)(XCD_BAR_WORDS + 16 * 256) * 4, stream);
  void* args[] = {&p};
  hipError_t e = hipLaunchCooperativeKernel((void*)k_mega, dim3(grid_blocks), dim3(256), args, 0, stream);
  if (e != hipSuccess) fprintf(stderr, "cooperative launch failed: %s (grid %d)\n", hipGetErrorString(e), grid_blocks);
#endif
}
```

```cpp
#include <hip/hip_runtime.h>
#include <hip/hip_cooperative_groups.h>
#include <cstdio>
#include <cstdint>
namespace cg = cooperative_groups;

#ifndef ONE_LAUNCH
#define ONE_LAUNCH 1
#endif

typedef unsigned short bf16_t;
using bf16x8 = __attribute__((ext_vector_type(8))) short;
using f32x4 = __attribute__((ext_vector_type(4))) float;
using f32x2 = __attribute__((ext_vector_type(2))) float;
using u32x4 = __attribute__((ext_vector_type(4))) unsigned;
using i32x8 = __attribute__((ext_vector_type(8))) int;
using f32x8 = __attribute__((ext_vector_type(8))) float;

#define NTOK 9216
#define NPROMPT 8192
#define DM 2048
#define INW 3584
#define EPSV 1e-6f

struct Params {
  const float *x_prompt, *x_sample, *cache_k, *cache_v, *state_conv, *state_h;
  const float *g_mix, *w_in, *g_q, *g_k, *sinks, *conv_w, *conv_b, *w_a, *b_a, *w_x, *b_x, *lam;
  const float *g_ao, *g_lo, *w_out, *g_ffn, *w_pq, *sub_keys, *peer_u, *peer_v;
  float* out;
  bf16_t *w_in_t, *w_out_t, *w_pq_t, *wg_t, *sk_bf, *act, *qb, *kb, *vb, *pq;
  float *z, *hloc, *pc, *chA, *chU, *mixraw, *sel_g;
  int* sel_eid;
  float* pd;
  bf16_t* zb;
  float* ssq;
  bf16_t* act2;
  unsigned char *u8, *v8;
  unsigned* bar;
};

#define OFF_Y 0
#define OFF_KP 18874368
#define OFF_VP 18939904
#define OFF_CP 19005440
#define OFF_HP 19011584
#define OFF_KS 19013632
#define OFF_VS 23207936
#define OFF_CS 27402240
#define OFF_HS 27795456

__device__ __forceinline__ int opaque_tid() { int t = threadIdx.x; asm volatile("" : "+v"(t)); return t; }
__device__ __forceinline__ bf16_t f2bf(float f) {
  unsigned u = __float_as_uint(f);
  u += 0x7FFFu + ((u >> 16) & 1u);
  return (bf16_t)(u >> 16);
}
__device__ __forceinline__ unsigned pack2bf(float a, float b) {
  return (unsigned)f2bf(a) | ((unsigned)f2bf(b) << 16);
}
__device__ __forceinline__ float bf2f_(bf16_t b) { return __uint_as_float((unsigned)b << 16); }
__device__ __forceinline__ float bflo(unsigned u) { return __uint_as_float(u << 16); }
__device__ __forceinline__ float bfhi(unsigned u) { return __uint_as_float(u & 0xFFFF0000u); }

__device__ __forceinline__ float wave_sum(float v) {
#pragma unroll
  for (int o = 32; o > 0; o >>= 1) v += __shfl_xor(v, o);
  return v;
}
__device__ __forceinline__ float row16_sum(float v) {
  v += __int_as_float(__builtin_amdgcn_update_dpp(0, __float_as_int(v), 0xB1, 0xF, 0xF, false));
  v += __int_as_float(__builtin_amdgcn_update_dpp(0, __float_as_int(v), 0x4E, 0xF, 0xF, false));
  v += __int_as_float(__builtin_amdgcn_update_dpp(0, __float_as_int(v), 0x141, 0xF, 0xF, false));
  v += __int_as_float(__builtin_amdgcn_update_dpp(0, __float_as_int(v), 0x140, 0xF, 0xF, false));
  return v;
}
__device__ __forceinline__ float gelu_tanh(float x) {
  float y = 0.7978845608028654f * (x + 0.044715f * x * x * x);
  float e = __expf(2.0f * y);
  float t = 1.0f - 2.0f / (e + 1.0f);
  return 0.5f * x * (1.0f + t);
}
__device__ __forceinline__ float sigmoidf_(float x) { return 1.0f / (1.0f + __expf(-x)); }

__device__ __forceinline__ const float* xrow(const Params& p, int tok) {
  return tok < NPROMPT ? p.x_prompt + (size_t)tok * DM : p.x_sample + (size_t)(tok - NPROMPT) * DM;
}

__device__ __forceinline__ void rms_row_to_bf16(const float* __restrict__ src, const float* __restrict__ g,
                                                bf16_t* __restrict__ dst, int lane) {
  float4 v[8];
  float ss = 0.f;
#pragma unroll
  for (int i = 0; i < 8; i++) {
    v[i] = *(const float4*)(src + i * 256 + lane * 4);
    ss += v[i].x * v[i].x + v[i].y * v[i].y + v[i].z * v[i].z + v[i].w * v[i].w;
  }
  ss = wave_sum(ss);
  float r = rsqrtf(ss * (1.0f / DM) + EPSV);
#pragma unroll
  for (int i = 0; i < 8; i++) {
    float4 gg = *(const float4*)(g + i * 256 + lane * 4);
    uint2 o;
    o.x = pack2bf(v[i].x * r * gg.x, v[i].y * r * gg.y);
    o.y = pack2bf(v[i].z * r * gg.z, v[i].w * r * gg.w);
    *(uint2*)(dst + i * 256 + lane * 4) = o;
  }
}

__device__ void convert_table_fp8(const float* __restrict__ src, unsigned char* __restrict__ dst, const float sc, int worker, int nworkers, const float* __restrict__ colg) {
  const int tid = opaque_tid();
  const size_t units = (size_t)16384 * 2048 / 16;
  const size_t stride = (size_t)nworkers * 256;
  for (size_t i = (size_t)worker * 256 + tid; i < units; i += 2 * stride) {
    const size_t j1 = (i + stride < units) ? i + stride : i;
    f32x4 a0[4], a1[4];
#pragma unroll
    for (int q = 0; q < 4; q++) a0[q] = __builtin_nontemporal_load((const f32x4*)(src + i * 16 + q * 4));
#pragma unroll
    for (int q = 0; q < 4; q++) a1[q] = __builtin_nontemporal_load((const f32x4*)(src + j1 * 16 + q * 4));
    if (colg) {
#pragma unroll
      for (int q = 0; q < 4; q++) {
        const f32x4 g0 = *(const f32x4*)(colg + ((i * 16 + q * 4) & 2047));
        const f32x4 g1 = *(const f32x4*)(colg + ((j1 * 16 + q * 4) & 2047));
        a0[q] *= g0; a1[q] *= g1;
      }
    }
    u32x4 o0, o1;
#pragma unroll
    for (int q = 0; q < 4; q++) {
      int w = 0;
      w = __builtin_amdgcn_cvt_pk_fp8_f32(fminf(fmaxf(a0[q][0] * sc, -448.f), 448.f), fminf(fmaxf(a0[q][1] * sc, -448.f), 448.f), w, false);
      w = __builtin_amdgcn_cvt_pk_fp8_f32(fminf(fmaxf(a0[q][2] * sc, -448.f), 448.f), fminf(fmaxf(a0[q][3] * sc, -448.f), 448.f), w, true);
      o0[q] = (unsigned)w;
      int w1 = 0;
      w1 = __builtin_amdgcn_cvt_pk_fp8_f32(fminf(fmaxf(a1[q][0] * sc, -448.f), 448.f), fminf(fmaxf(a1[q][1] * sc, -448.f), 448.f), w1, false);
      w1 = __builtin_amdgcn_cvt_pk_fp8_f32(fminf(fmaxf(a1[q][2] * sc, -448.f), 448.f), fminf(fmaxf(a1[q][3] * sc, -448.f), 448.f), w1, true);
      o1[q] = (unsigned)w1;
    }
    *(u32x4*)(dst + i * 16) = o0;
    *(u32x4*)(dst + j1 * 16) = o1;
  }
}

__device__ void copy_cache_rows(const Params& p, int bid, int nb) {
  const int tid = opaque_tid();
  {
    const int per_b = 120 * 256 / 4;
    const int half = 128 * per_b, quarter = half / 2;
    for (int i = bid * 256 + tid; i < quarter; i += nb * 256) {
      const int j0 = i, j1 = i + quarter;
      const int b0 = j0 / per_b, r0 = j0 % per_b, b1 = j1 / per_b, r1 = j1 % per_b;
      const size_t s0 = (size_t)b0 * 32768 + 8 * 256 + r0 * 4, s1 = (size_t)b1 * 32768 + 8 * 256 + r1 * 4;
      const size_t d0 = (size_t)b0 * 32768 + r0 * 4, d1 = (size_t)b1 * 32768 + r1 * 4;
      const f32x4 v0 = *(const f32x4*)(p.cache_k + s0);
      const f32x4 v1 = *(const f32x4*)(p.cache_k + s1);
      const f32x4 v2 = *(const f32x4*)(p.cache_v + s0);
      const f32x4 v3 = *(const f32x4*)(p.cache_v + s1);
      *(f32x4*)(p.out + OFF_KS + d0) = v0;
      *(f32x4*)(p.out + OFF_KS + d1) = v1;
      *(f32x4*)(p.out + OFF_VS + d0) = v2;
      *(f32x4*)(p.out + OFF_VS + d1) = v3;
    }
  }
}

__device__ void phase_convert(const Params& p, char* smem, int bid, int nb) {
  const int tid = opaque_tid(), lane = tid & 63, wave = tid >> 6;
  float* tile = (float*)smem;
  const int T_IN = 32 * 56, T_OUT = 32 * 32, T_PQ = 32 * 32;
  for (int t = bid; t < T_IN + T_OUT + T_PQ; t += nb) {
    const float* W; bf16_t* Wt; int N; int tt = t;
    int gsel;
    if (tt < T_IN) { W = p.w_in; Wt = p.w_in_t; N = INW; gsel = 0; }
    else if (tt < T_IN + T_OUT) { tt -= T_IN; W = p.w_out; Wt = p.w_out_t; N = DM; gsel = 1; }
    else { tt -= T_IN + T_OUT; W = p.w_pq; Wt = p.w_pq_t; N = DM; gsel = 2; }
    const int ntn = N / 64;
    const int kt = tt / ntn, nt = tt % ntn;
    {
      const int krow = tid >> 4, nq = tid & 15;
      float4 v[4];
#pragma unroll
      for (int i = 0; i < 4; i++) v[i] = *(const float4*)(W + (size_t)(kt * 64 + krow + 16 * i) * N + nt * 64 + nq * 4);
#pragma unroll
      for (int i = 0; i < 4; i++) {
        const int kk = kt * 64 + krow + 16 * i;
        const float gk = (gsel == 0) ? 1.0f : (gsel == 2) ? p.g_ffn[kk] : (kk < 1024 ? p.g_ao[kk] : p.g_lo[kk - 1024]);
        float* tp = tile + (krow + 16 * i) * 65 + nq * 4;
        tp[0] = v[i].x * gk; tp[1] = v[i].y * gk; tp[2] = v[i].z * gk; tp[3] = v[i].w * gk;
      }
    }
    __syncthreads();
    {
      const int n = tid >> 2, kq = tid & 3;
      u32x4 o0, o1;
#pragma unroll
      for (int e = 0; e < 4; e++) {
        o0[e] = pack2bf(tile[(kq * 16 + 2 * e) * 65 + n], tile[(kq * 16 + 2 * e + 1) * 65 + n]);
        o1[e] = pack2bf(tile[(kq * 16 + 8 + 2 * e) * 65 + n], tile[(kq * 16 + 8 + 2 * e + 1) * 65 + n]);
      }
      bf16_t* wp = Wt + (size_t)(nt * 64 + n) * DM + kt * 64 + kq * 16;
      *(u32x4*)(wp) = o0;
      *(u32x4*)(wp + 8) = o1;
    }
    __syncthreads();
  }
  {
    for (int i = bid * 256 + tid; i < 262144 / 8; i += nb * 256) {
      float4 a = *(const float4*)(p.sub_keys + (size_t)i * 8);
      float4 b = *(const float4*)(p.sub_keys + (size_t)i * 8 + 4);
      uint4 o;
      o.x = pack2bf(a.x, a.y); o.y = pack2bf(a.z, a.w); o.z = pack2bf(b.x, b.y); o.w = pack2bf(b.z, b.w);
      *(uint4*)(p.sk_bf + (size_t)i * 8) = o;
    }
  }
  for (int i = bid * 256 + tid; i < 3 * NTOK; i += nb * 256) p.ssq[i] = 0.f;
  for (int i = bid * 256 + tid; i < 131072; i += nb * 256) {
    const int d = i & 63, e = (i >> 6) & 63, n = (i >> 12) & 15, g = i >> 16;
    const float* W = g ? p.w_x : p.w_a;
    p.wg_t[i] = f2bf(W[(size_t)(n * 64 + d) * 64 + e]);
  }
  for (int tok = bid * 4 + wave; tok < NTOK; tok += nb * 4)
    rms_row_to_bf16(xrow(p, tok), p.g_mix, p.act + (size_t)tok * DM, lane);
}

#define GEMM_GLOAD(S, koff)                                          \
  S##a0 = *(const u32x4*)(ga + (koff));                              \
  S##a1 = *(const u32x4*)(ga + (koff) + (size_t)32 * DM);            \
  S##a2 = *(const u32x4*)(ga + (koff) + (size_t)64 * DM);            \
  if (MI == 4) S##a3 = *(const u32x4*)(ga + (koff) + (size_t)96 * DM); \
  S##b0 = *(const u32x4*)(gb + (koff));                              \
  S##b1 = *(const u32x4*)(gb + (koff) + (size_t)32 * DM);            \
  S##b2 = *(const u32x4*)(gb + (koff) + (size_t)64 * DM);            \
  S##b3 = *(const u32x4*)(gb + (koff) + (size_t)96 * DM);
#define GEMM_LSTORE(S, boff)                                         \
  *(u32x4*)(sA + (boff) + loff) = S##a0;                             \
  *(u32x4*)(sA + (boff) + loff + 32 * 64) = S##a1;                   \
  *(u32x4*)(sA + (boff) + loff + 64 * 64) = S##a2;                   \
  if (MI == 4) *(u32x4*)(sA + (boff) + loff + 96 * 64) = S##a3;      \
  *(u32x4*)(sB + (boff) + loff) = S##b0;                             \
  *(u32x4*)(sB + (boff) + loff + 32 * 64) = S##b1;                   \
  *(u32x4*)(sB + (boff) + loff + 64 * 64) = S##b2;                   \
  *(u32x4*)(sB + (boff) + loff + 96 * 64) = S##b3;
#define GEMM_COMPUTE(cA, cB)                                                                      \
  _Pragma("unroll") for (int ks = 0; ks < 2; ks++) {                                               \
    bf16x8 af[MI], bfr[4];                                                                         \
    const int kc = ks * 4 + (lane >> 4);                                                           \
    _Pragma("unroll") for (int mi = 0; mi < MI; mi++) {                                            \
      const int row = wm * (MI * 16) + mi * 16 + (lane & 15);                                      \
      af[mi] = *(const bf16x8*)((cA) + row * 64 + ((kc ^ (row & 7)) * 8));                         \
    }                                                                                              \
    _Pragma("unroll") for (int ni = 0; ni < 4; ni++) {                                             \
      const int row = wn * 64 + ni * 16 + (lane & 15);                                             \
      bfr[ni] = *(const bf16x8*)((cB) + row * 64 + ((kc ^ (row & 7)) * 8));                        \
    }                                                                                              \
    _Pragma("unroll") for (int mi = 0; mi < MI; mi++)                                              \
      _Pragma("unroll") for (int ni = 0; ni < 4; ni++)                                             \
        acc[mi][ni] = __builtin_amdgcn_mfma_f32_16x16x32_bf16(af[mi], bfr[ni], acc[mi][ni], 0, 0, 0); \
  }
template <int MODE, int MI>
__device__ void gemm_phase(const Params& p, char* smem, int bid, int nb, const bf16_t* __restrict__ A,
                           const bf16_t* __restrict__ Bt, const int N) {
  constexpr int K = DM;
  bf16_t* sA = (bf16_t*)smem;
  bf16_t* sB = sA + 2 * 8192;
  const int tid = opaque_tid(), lane = tid & 63, wave = tid >> 6;
  const int wm = wave >> 1, wn = wave & 1;
  const int ntn = N / 128;
  constexpr int BM = MI * 32;
  const int ntiles = (NTOK / BM) * ntn;
  const int lrow = tid >> 3, lkc = tid & 7;
  const u32x4 z4_ = u32x4{0, 0, 0, 0};
  u32x4 p0a0 = z4_, p0a1 = z4_, p0a2 = z4_, p0a3 = z4_, p0b0 = z4_, p0b1 = z4_, p0b2 = z4_, p0b3 = z4_;
  u32x4 p1a0 = z4_, p1a1 = z4_, p1a2 = z4_, p1a3 = z4_, p1b0 = z4_, p1b1 = z4_, p1b2 = z4_, p1b3 = z4_;
  const int loff = lrow * 64 + ((lkc ^ (lrow & 7)) * 8);
  constexpr int KT = K / 64;
  const bf16_t* ga = A;
  const bf16_t* gb = Bt;
  if (bid < ntiles) {
    ga = A + (size_t)((bid / ntn) * BM + lrow) * K + lkc * 8;
    gb = Bt + (size_t)((bid % ntn) * 128 + lrow) * K + lkc * 8;
    GEMM_GLOAD(p0, 0)
    GEMM_GLOAD(p1, 64)
  }
  for (int t = bid; t < ntiles; t += nb) {
    const int mt = t / ntn, nt = t % ntn;
    const int m0 = mt * BM, n0 = nt * 128;
    f32x4 acc[MI][4];
#pragma unroll
    for (int i = 0; i < MI; i++)
#pragma unroll
      for (int j = 0; j < 4; j++) acc[i][j] = f32x4{0.f, 0.f, 0.f, 0.f};
    GEMM_LSTORE(p0, 0)
    __syncthreads();
#pragma unroll 1
    for (int kt = 0; kt < KT; kt += 2) {
      if (MODE == 1 && kt == KT / 2) {
#pragma unroll
        for (int mi = 0; mi < MI; mi++)
#pragma unroll
          for (int j = 0; j < 4; j++) {
            const int row = m0 + wm * (MI * 16) + mi * 16 + (lane >> 4) * 4 + j;
            const float ra = rsqrtf(p.ssq[row] * (1.0f / 1024.0f) + EPSV);
            const float rl = rsqrtf(p.ssq[NTOK + row] * (1.0f / 1024.0f) + EPSV);
            const float ratio = ra / rl;
#pragma unroll
            for (int ni = 0; ni < 4; ni++) acc[mi][ni][j] *= ratio;
          }
      }
      { const int k2 = min(kt + 2, KT - 1) * 64; GEMM_GLOAD(p0, k2) }
      GEMM_COMPUTE(sA, sB)
      GEMM_LSTORE(p1, 8192)
      __syncthreads();
      { const int k3 = min(kt + 3, KT - 1) * 64; GEMM_GLOAD(p1, k3) }
      GEMM_COMPUTE(sA + 8192, sB + 8192)
      GEMM_LSTORE(p0, 0)
      __syncthreads();
    }
    {
      const int tn = t + nb;
      if (tn < ntiles) {
        ga = A + (size_t)((tn / ntn) * BM + lrow) * K + lkc * 8;
        gb = Bt + (size_t)((tn % ntn) * 128 + lrow) * K + lkc * 8;
        GEMM_GLOAD(p0, 0)
        GEMM_GLOAD(p1, 64)
      }
    }
#pragma unroll
    for (int mi = 0; mi < MI; mi++)
#pragma unroll
      for (int j = 0; j < 4; j++) {
        const int row = m0 + wm * (MI * 16) + mi * 16 + (lane >> 4) * 4 + j;
        float rs = 1.0f, sq = 0.f;
        if (MODE == 1) rs = rsqrtf(p.ssq[NTOK + row] * (1.0f / 1024.0f) + EPSV);
        if (MODE == 2) rs = rsqrtf(p.ssq[2 * NTOK + row] * (1.0f / 2048.0f) + EPSV);
#pragma unroll
        for (int ni = 0; ni < 4; ni++) {
          const int col = n0 + wn * 64 + ni * 16 + (lane & 15);
          const float v = acc[mi][ni][j] * rs;
          if (MODE == 0) p.zb[(size_t)row * INW + col] = f2bf(v);
          else if (MODE == 1) {
            const float x1 = xrow(p, row)[col] + v;
            p.out[OFF_Y + (size_t)row * DM + col] = x1;
            p.act2[(size_t)row * DM + col] = f2bf(x1);
            sq += x1 * x1;
          } else p.pq[(size_t)row * DM + col] = f2bf(v);
        }
        if (MODE == 1) {
          sq = row16_sum(sq);
          if ((lane & 15) == 0) atomicAdd(&p.ssq[2 * NTOK + row], sq);
        }
      }
  }
  if (false && MODE != 0) {
    const int rem = ntiles % nb;
    if (rem == 0 || bid >= rem) {
      const int worker = rem ? bid - rem : bid, nworkers = rem ? nb - rem : nb;
      if (MODE == 1) convert_table_fp8(p.peer_u, p.u8, 256.0f, worker, nworkers, p.g_ffn);
      else convert_table_fp8(p.peer_v, p.v8, 16.0f, worker, nworkers, nullptr);
    }
  }
}

__device__ void phase_qkprep(const Params& p, int bid, int nb) {
  const int tid = opaque_tid(), lane = tid & 63, wave = tid >> 6;
  const float gq = p.g_q[lane], gk = p.g_k[lane];
  const float inv = expf(-9.210340371976184f * (float)(lane & 31) * (2.0f / 64.0f));
  for (int tok = bid * 4 + wave; tok < NTOK; tok += nb * 4) {
    const bool prompt = tok < NPROMPT;
    const int b = prompt ? (tok >> 12) : ((tok - NPROMPT) >> 3);
    const int t = prompt ? (tok & 4095) : ((tok - NPROMPT) & 7);
    const float pos = prompt ? (float)t : (float)(8192 + t);
    float sn, cs;
    sincosf(pos * inv, &sn, &cs);
    const bf16_t* zr = p.zb + (size_t)tok * INW;
    float v[20], vv[4], ss[20];
#pragma unroll
    for (int h = 0; h < 20; h++) v[h] = bf2f_(zr[h * 64 + lane]);
#pragma unroll
    for (int kh = 0; kh < 4; kh++) vv[kh] = bf2f_(zr[1280 + kh * 64 + lane]);
#pragma unroll
    for (int h = 0; h < 20; h++) ss[h] = v[h] * v[h];
#pragma unroll
    for (int o = 32; o > 0; o >>= 1)
#pragma unroll
      for (int h = 0; h < 20; h++) ss[h] += __shfl_xor(ss[h], o);
#pragma unroll
    for (int h = 0; h < 20; h++) {
      const float y = v[h] * rsqrtf(ss[h] * (1.0f / 64.0f) + EPSV) * (h < 16 ? gq : gk);
      const float o = __shfl_xor(y, 32);
      const float r = (lane < 32) ? (y * cs - o * sn) : (y * cs + o * sn);
      if (h < 16) {
        p.qb[(size_t)tok * 1024 + h * 64 + lane] = f2bf(r);
      } else {
        const int kh = h - 16;
        p.kb[(size_t)tok * 256 + kh * 64 + lane] = f2bf(r);
        p.vb[(size_t)tok * 256 + kh * 64 + lane] = f2bf(vv[kh]);
        if (prompt) {
          if (t >= 4096 - 128) {
            const size_t o2 = ((size_t)b * 128 + (t - 3968)) * 256 + kh * 64 + lane;
            p.out[OFF_KP + o2] = r;
            p.out[OFF_VP + o2] = vv[kh];
          }
        } else {
          const size_t o2 = ((size_t)b * 128 + 120 + t) * 256 + kh * 64 + lane;
          p.out[OFF_KS + o2] = r;
          p.out[OFF_VS + o2] = vv[kh];
        }
      }
    }
  }
}

#define LRS 68
__device__ void phase_lru_local(const Params& p, char* smem, int bid, int nb) {
  const int tid = opaque_tid(), lane = tid & 63, wave = tid >> 6;
  const int r15 = lane & 15, q4 = lane >> 4;
  char* wb = smem + wave * (2048 + 2 * 16 * LRS * 4);
  bf16_t* xcb = (bf16_t*)wb;
  float* xcf = (float*)(wb + 2048);
  float* ga = xcf + 16 * LRS;
  for (int u = bid * 4 + wave; u < 4096; u += nb * 4) {
    const bool prompt = u < 2048;
    const int n = u & 15;
    const int ch = n * 64 + lane;
    int b, chunk, tok0, T;
    if (prompt) { b = u >> 10; chunk = (u >> 4) & 63; tok0 = b * 4096 + chunk * 64; T = 64; }
    else { b = (u - 2048) >> 4; chunk = 0; tok0 = NPROMPT + b * 8; T = 8; }
    bf16x8 Bf[2][4][2];
#pragma unroll
    for (int g = 0; g < 2; g++)
#pragma unroll
      for (int nt = 0; nt < 4; nt++)
#pragma unroll
        for (int ks = 0; ks < 2; ks++)
          Bf[g][nt][ks] = *(const bf16x8*)(p.wg_t + ((size_t)((g * 16 + n) * 64 + nt * 16 + r15)) * 64 + ks * 32 + q4 * 8);
    float bav[4], bxv[4], spv[4];
#pragma unroll
    for (int nt = 0; nt < 4; nt++) {
      const int e = n * 64 + nt * 16 + r15;
      bav[nt] = p.b_a[e]; bxv[nt] = p.b_x[e];
      spv[nt] = -8.0f * log1pf(expf(-p.lam[e]));
    }
    const float cb = p.conv_b[ch];
    const float cw0 = p.conv_w[ch], cw1 = p.conv_w[1024 + ch], cw2 = p.conv_w[2048 + ch], cw3 = p.conv_w[3072 + ch];
    float xm3 = 0.f, xm2 = 0.f, xm1 = 0.f, h = 0.f, P = 1.f;
    if (!prompt) {
      xm3 = p.state_conv[((size_t)b * 3 + 0) * 1024 + ch];
      xm2 = p.state_conv[((size_t)b * 3 + 1) * 1024 + ch];
      xm1 = p.state_conv[((size_t)b * 3 + 2) * 1024 + ch];
      h = p.state_h[(size_t)b * 1024 + ch];
    } else if (chunk > 0) {
      xm3 = bf2f_(p.zb[(size_t)(tok0 - 3) * INW + 1536 + ch]);
      xm2 = bf2f_(p.zb[(size_t)(tok0 - 2) * INW + 1536 + ch]);
      xm1 = bf2f_(p.zb[(size_t)(tok0 - 1) * INW + 1536 + ch]);
    }
#pragma unroll 1
    for (int t0 = 0; t0 < T; t0 += 16) {
      const int nv = min(16, T - t0);
      float xr[16];
#pragma unroll
      for (int i = 0; i < 16; i++) xr[i] = (i < nv) ? bf2f_(p.zb[(size_t)(tok0 + t0 + i) * INW + 1536 + ch]) : 0.f;
#pragma unroll
      for (int i = 0; i < 16; i++) {
        const float xc = cw0 * xm3 + cw1 * xm2 + cw2 * xm1 + cw3 * xr[i] + cb;
        if (i < nv) { xm3 = xm2; xm2 = xm1; xm1 = xr[i]; }
        xcf[i * LRS + lane] = xc;
        xcb[i * 64 + (((lane >> 3) ^ (i & 7)) * 8) + (lane & 7)] = f2bf(xc);
      }
      __builtin_amdgcn_fence(__ATOMIC_RELEASE, "wavefront");
      __builtin_amdgcn_wave_barrier();
      __builtin_amdgcn_fence(__ATOMIC_ACQUIRE, "wavefront");
      const bf16x8 A0 = *(const bf16x8*)(xcb + r15 * 64 + ((q4 ^ (r15 & 7)) * 8));
      const bf16x8 A1 = *(const bf16x8*)(xcb + r15 * 64 + (((4 + q4) ^ (r15 & 7)) * 8));
#pragma unroll
      for (int nt = 0; nt < 4; nt++) {
        f32x4 aa = f32x4{0.f, 0.f, 0.f, 0.f}, ax = f32x4{0.f, 0.f, 0.f, 0.f};
        aa = __builtin_amdgcn_mfma_f32_16x16x32_bf16(A0, Bf[0][nt][0], aa, 0, 0, 0);
        aa = __builtin_amdgcn_mfma_f32_16x16x32_bf16(A1, Bf[0][nt][1], aa, 0, 0, 0);
        ax = __builtin_amdgcn_mfma_f32_16x16x32_bf16(A0, Bf[1][nt][0], ax, 0, 0, 0);
        ax = __builtin_amdgcn_mfma_f32_16x16x32_bf16(A1, Bf[1][nt][1], ax, 0, 0, 0);
#pragma unroll
        for (int j = 0; j < 4; j++) {
          const int o = (q4 * 4 + j) * LRS + nt * 16 + r15;
          const float r = sigmoidf_(aa[j] + bav[nt]);
          const float ig = sigmoidf_(ax[j] + bxv[nt]);
          const float la = r * spv[nt];
          const float a = __expf(la);
          const float x2 = 2.0f * la;
          const float om = (x2 > -0.02f) ? (-x2 * (1.0f + x2 * (0.5f + x2 * (1.0f / 6.0f)))) : (1.0f - a * a);
          const float uu = sqrtf(om) * ig * xcf[o];
          ga[o] = a;
          xcf[o] = uu;
        }
      }
      __builtin_amdgcn_fence(__ATOMIC_RELEASE, "wavefront");
      __builtin_amdgcn_wave_barrier();
      __builtin_amdgcn_fence(__ATOMIC_ACQUIRE, "wavefront");
#pragma unroll
      for (int i = 0; i < 16; i++) {
        if (i < nv) {
          const float a = ga[i * LRS + lane];
          const float uu = xcf[i * LRS + lane];
          h = a * h + uu;
          P *= a;
          const size_t o = (size_t)(tok0 + t0 + i) * 1024 + ch;
          ((bf16_t*)p.hloc)[o] = f2bf(h);
          ((bf16_t*)p.pc)[o] = f2bf(P);
        }
      }
      __builtin_amdgcn_fence(__ATOMIC_RELEASE, "wavefront");
      __builtin_amdgcn_wave_barrier();
    }
    if (prompt) {
      p.chA[((size_t)b * 64 + chunk) * 1024 + ch] = P;
      p.chU[((size_t)b * 64 + chunk) * 1024 + ch] = h;
    }
  }
}

#define VS 200
template <int NT>
__device__ __forceinline__ void attn_qtile(const bf16_t* sK, const bf16_t* sVt, const bf16_t* qptr, const int i_idx,
                                           const int jmin, const float sink, f32x4 (&o)[4], const int lane) {
  const int r15 = lane & 15, q4 = lane >> 4;
  bf16x8 qf[2];
  qf[0] = *(const bf16x8*)(qptr);
  qf[1] = *(const bf16x8*)(qptr + 32);
  const bf16_t* kb0 = sK + r15 * 64 + ((q4 ^ (r15 & 7)) * 8);
  const bf16_t* kb1 = sK + r15 * 64 + (((4 + q4) ^ (r15 & 7)) * 8);
  f32x4 s[NT];
#pragma unroll
  for (int t = 0; t < NT; t++) {
    s[t] = f32x4{0.f, 0.f, 0.f, 0.f};
    bf16x8 a0 = *(const bf16x8*)(kb0 + t * 1024);
    bf16x8 a1 = *(const bf16x8*)(kb1 + t * 1024);
    s[t] = __builtin_amdgcn_mfma_f32_16x16x32_bf16(a0, qf[0], s[t], 0, 0, 0);
    s[t] = __builtin_amdgcn_mfma_f32_16x16x32_bf16(a1, qf[1], s[t], 0, 0, 0);
    if (t & 1) __builtin_amdgcn_sched_barrier(0);
  }
  float m = sink;
  const int jb = q4 * 4 - i_idx;
#pragma unroll
  for (int t = 0; t < NT; t++)
#pragma unroll
    for (int j = 0; j < 4; j++) {
      const int dj = t * 16 + j + jb;
      const bool valid = (dj > 0) && (dj <= 128) && (dj + i_idx >= jmin);
      float v = valid ? s[t][j] * 0.125f : -1e30f;
      s[t][j] = v;
      m = fmaxf(m, v);
    }
  m = fmaxf(m, __shfl_xor(m, 16));
  m = fmaxf(m, __shfl_xor(m, 32));
  float sum = 0.f;
#pragma unroll
  for (int t = 0; t < NT; t++)
#pragma unroll
    for (int j = 0; j < 4; j++) {
      float e = __expf(s[t][j] - m);
      s[t][j] = e;
      sum += e;
    }
  sum += __shfl_xor(sum, 16);
  sum += __shfl_xor(sum, 32);
  sum += __expf(sink - m);
  const float inv = 1.0f / sum;
  const bf16_t* vbase = sVt + r15 * VS + q4 * 4;
#pragma unroll
  for (int kk = 0; kk < NT / 2; kk++) {
    union { bf16x8 v; unsigned u[4]; } pa;
    pa.u[0] = pack2bf(s[2 * kk][0] * inv, s[2 * kk][1] * inv);
    pa.u[1] = pack2bf(s[2 * kk][2] * inv, s[2 * kk][3] * inv);
    pa.u[2] = pack2bf(s[2 * kk + 1][0] * inv, s[2 * kk + 1][1] * inv);
    pa.u[3] = pack2bf(s[2 * kk + 1][2] * inv, s[2 * kk + 1][3] * inv);
#pragma unroll
    for (int dt = 0; dt < 4; dt++) {
      union { bf16x8 v; uint2 h[2]; } bv;
      bv.h[0] = *(const uint2*)(vbase + dt * 16 * VS + kk * 32);
      bv.h[1] = *(const uint2*)(vbase + dt * 16 * VS + kk * 32 + 16);
      o[dt] = __builtin_amdgcn_mfma_f32_16x16x32_bf16(pa.v, bv.v, o[dt], 0, 0, 0);
    }
    __builtin_amdgcn_sched_barrier(0);
  }
}

__device__ __forceinline__ void kv_to_lds(bf16_t* sK, bf16_t* sVt, int key, int dc, const uint4& kv, const uint4& vv) {
  *(uint4*)(sK + key * 64 + ((dc ^ (key & 7)) * 8)) = kv;
  bf16_t* vp = sVt + (dc * 8) * VS + key;
  vp[0 * VS] = (bf16_t)(vv.x & 0xFFFF); vp[1 * VS] = (bf16_t)(vv.x >> 16);
  vp[2 * VS] = (bf16_t)(vv.y & 0xFFFF); vp[3 * VS] = (bf16_t)(vv.y >> 16);
  vp[4 * VS] = (bf16_t)(vv.z & 0xFFFF); vp[5 * VS] = (bf16_t)(vv.z >> 16);
  vp[6 * VS] = (bf16_t)(vv.w & 0xFFFF); vp[7 * VS] = (bf16_t)(vv.w >> 16);
}

__device__ void phase_attn(const Params& p, char* smem, int bid, int nb) {
  const int tid = opaque_tid(), lane = tid & 63, wave = tid >> 6;
  bf16_t* sK = (bf16_t*)smem;
  bf16_t* sVt = sK + 192 * 64;
  for (int unit = bid; unit < 512 + 512; unit += nb) {
    __syncthreads();
    if (unit < 512) {
      const int kvh = unit & 3, n = (unit >> 2) & 63, b = unit >> 8;
      if (tid < 192) {
#pragma unroll 2
        for (int i = 0; i < 8; i++) {
          const int key = tid, dc = i;
          const int tk = n * 64 - 128 + key;
          uint4 kv = uint4{0, 0, 0, 0}, vv = uint4{0, 0, 0, 0};
          if (tk >= 0) {
            kv = *(const uint4*)(p.kb + (size_t)(b * 4096 + tk) * 256 + kvh * 64 + dc * 8);
            vv = *(const uint4*)(p.vb + (size_t)(b * 4096 + tk) * 256 + kvh * 64 + dc * 8);
          }
          kv_to_lds(sK, sVt, key, dc, kv, vv);
        }
      }
      __syncthreads();
      const int hq = kvh * 4 + wave;
      const float sink = p.sinks[hq];
      const int jmin = 128 - n * 64;
#pragma unroll 1
      for (int qt = 0; qt < 4; qt++) {
        const int i_idx = qt * 16 + (lane & 15);
        const int tokq = b * 4096 + n * 64 + i_idx;
        f32x4 o[4];
#pragma unroll
        for (int dt = 0; dt < 4; dt++) o[dt] = f32x4{0.f, 0.f, 0.f, 0.f};
        attn_qtile<12>(sK, sVt, p.qb + (size_t)tokq * 1024 + hq * 64 + (lane >> 4) * 8, i_idx, jmin, sink, o, lane);
        const int tokbase = b * 4096 + n * 64 + qt * 16;
        bf16_t* op = p.act + (size_t)(tokbase + (lane >> 4) * 4) * DM + hq * 64 + (lane & 15);
#pragma unroll
        for (int j = 0; j < 4; j++) {
          float sq = 0.f;
#pragma unroll
          for (int dt = 0; dt < 4; dt++) { op[(size_t)j * DM + dt * 16] = f2bf(o[dt][j]); sq += o[dt][j] * o[dt][j]; }
          sq = row16_sum(sq);
          if ((lane & 15) == 0) atomicAdd(&p.ssq[tokbase + (lane >> 4) * 4 + j], sq);
        }
      }
    } else {
      const int us = unit - 512;
      const int kvh = us & 3, b = us >> 2;
#pragma unroll 1
      for (int i = 0; i < 5; i++) {
        const int id = tid + i * 256;
        const int key = id % 160, dc = id / 160;
        uint4 kv = uint4{0, 0, 0, 0}, vv = uint4{0, 0, 0, 0};
        if (key < 128) {
          const float* ck = p.cache_k + (((size_t)b * 128 + key) * 4 + kvh) * 64 + dc * 8;
          const float* cv = p.cache_v + (((size_t)b * 128 + key) * 4 + kvh) * 64 + dc * 8;
          float4 a0 = *(const float4*)ck, a1 = *(const float4*)(ck + 4);
          float4 b0 = *(const float4*)cv, b1 = *(const float4*)(cv + 4);
          kv.x = pack2bf(a0.x, a0.y); kv.y = pack2bf(a0.z, a0.w); kv.z = pack2bf(a1.x, a1.y); kv.w = pack2bf(a1.z, a1.w);
          vv.x = pack2bf(b0.x, b0.y); vv.y = pack2bf(b0.z, b0.w); vv.z = pack2bf(b1.x, b1.y); vv.w = pack2bf(b1.z, b1.w);
        } else if (key < 136) {
          kv = *(const uint4*)(p.kb + (size_t)(NPROMPT + b * 8 + key - 128) * 256 + kvh * 64 + dc * 8);
          vv = *(const uint4*)(p.vb + (size_t)(NPROMPT + b * 8 + key - 128) * 256 + kvh * 64 + dc * 8);
        }
        kv_to_lds(sK, sVt, key, dc, kv, vv);
      }
      __syncthreads();
      if (wave < 2) {
        const int r = lane & 15;
        const int hq = kvh * 4 + wave * 2 + (r >> 3);
        const int s_idx = r & 7;
        const int tokq = NPROMPT + b * 8 + s_idx;
        f32x4 o[4];
#pragma unroll
        for (int dt = 0; dt < 4; dt++) o[dt] = f32x4{0.f, 0.f, 0.f, 0.f};
        attn_qtile<10>(sK, sVt, p.qb + (size_t)tokq * 1024 + hq * 64 + (lane >> 4) * 8, s_idx, 0, p.sinks[hq], o, lane);
#pragma unroll
        for (int j = 0; j < 4; j++) {
          const int rr = (lane >> 4) * 4 + j;
          const int hq2 = kvh * 4 + wave * 2 + (rr >> 3);
          bf16_t* op = p.act + (size_t)(NPROMPT + b * 8 + (rr & 7)) * DM + hq2 * 64 + (lane & 15);
          float sq = 0.f;
#pragma unroll
          for (int dt = 0; dt < 4; dt++) { op[dt * 16] = f2bf(o[dt][j]); sq += o[dt][j] * o[dt][j]; }
          sq = row16_sum(sq);
          if ((lane & 15) == 0) atomicAdd(&p.ssq[NPROMPT + b * 8 + (rr & 7)], sq);
        }
      }
    }
  }
}

__device__ void phase_lru_apply(const Params& p, int bid, int nb) {
  const int tid = opaque_tid(), lane = tid & 63, wave = tid >> 6;
  for (int u = bid * 4 + wave; u < 4096; u += nb * 4) {
    const bool prompt = u < 2048;
    const int n = u & 15;
    const int ch = n * 64 + lane;
    int b, chunk, tok0, T;
    if (prompt) { b = u >> 10; chunk = (u >> 4) & 63; tok0 = b * 4096 + chunk * 64; T = 64; }
    else { b = (u - 2048) >> 4; chunk = 0; tok0 = NPROMPT + b * 8; T = 8; }
    float hin = 0.f;
    if (prompt) {
#pragma unroll 1
      for (int k0 = 0; k0 < chunk; k0 += 16) {
        float av[16], uv[16];
#pragma unroll
        for (int k = 0; k < 16; k++) {
          const bool ok = (k0 + k) < chunk;
          const size_t o = ((size_t)b * 64 + (ok ? k0 + k : 0)) * 1024 + ch;
          av[k] = p.chA[o]; uv[k] = p.chU[o];
          if (!ok) { av[k] = 1.f; uv[k] = 0.f; }
        }
#pragma unroll
        for (int k = 0; k < 16; k++) hin = av[k] * hin + uv[k];
      }
    }
    float h = 0.f;
#pragma unroll 8
    for (int t = 0; t < T; t++) {
      const size_t tok = tok0 + t;
      h = bf2f_(((const bf16_t*)p.hloc)[tok * 1024 + ch]) + bf2f_(((const bf16_t*)p.pc)[tok * 1024 + ch]) * hin;
      float yg = bf2f_(p.zb[tok * INW + 2560 + ch]);
      const float yv = h * gelu_tanh(yg);
      p.act[tok * DM + 1024 + ch] = f2bf(yv);
      const float sq = wave_sum(yv * yv);
      if (lane == 0) atomicAdd(&p.ssq[NTOK + tok], sq);
    }
    if (prompt) {
      if (chunk == 63) {
        p.out[OFF_HP + (size_t)b * 1024 + ch] = h;
#pragma unroll
        for (int j = 0; j < 3; j++)
          p.out[OFF_CP + ((size_t)b * 3 + j) * 1024 + ch] = bf2f_(p.zb[(size_t)(b * 4096 + 4093 + j) * INW + 1536 + ch]);
      }
    } else {
      p.out[OFF_HS + (size_t)b * 1024 + ch] = h;
#pragma unroll
      for (int j = 0; j < 3; j++)
        p.out[OFF_CS + ((size_t)b * 3 + j) * 1024 + ch] = bf2f_(p.zb[(size_t)(NPROMPT + b * 8 + 5 + j) * INW + 1536 + ch]);
    }
  }
}

__device__ __forceinline__ int ordf(float f) { int b = __float_as_int(f); return b ^ ((b >> 31) & 0x7FFFFFFF); }
__device__ __forceinline__ float unordf(int o) { return __int_as_float(o ^ ((o >> 31) & 0x7FFFFFFF)); }
template <int CTRL>
__device__ __forceinline__ int dppi(int v) { return __builtin_amdgcn_update_dpp(v, v, CTRL, 0xF, 0xF, false); }
__device__ __forceinline__ int row16_allmax(int m) {
  m = max(m, dppi<0xB1>(m));
  m = max(m, dppi<0x4E>(m));
  m = max(m, dppi<0x141>(m));
  m = max(m, dppi<0x140>(m));
  return m;
}
__device__ __forceinline__ int quad_allmax(int m) {
  m = max(m, dppi<0xB1>(m));
  m = max(m, dppi<0x4E>(m));
  return m;
}

__device__ void phase_peer_select(const Params& p, char* smem, int bid, int nb) {
  const int tid = opaque_tid(), lane = tid & 63, wave = tid >> 6;
  int* tab = (int*)smem;
  int* st = tab + 64 + wave * 512;
  if (tid < 64) {
    int e = -1, cnt = 0;
    for (int i = 0; i < 16; i++) {
      int nn = 16 / (i + 1);
      if (tid >= cnt && tid < cnt + nn) e = i | ((tid - cnt) << 4);
      cnt += nn;
    }
    tab[tid] = e;
  }
  __syncthreads();
  const int r15 = lane & 15, q4 = lane >> 4;
  for (int unit = bid * 4 + wave; unit < 576 * 8; unit += nb * 4) {
    const int tt = unit >> 3, hh = unit & 7;
#pragma unroll 1
    for (int c = 0; c < 2; c++) {
      f32x4 acc[8];
#pragma unroll
      for (int kt = 0; kt < 8; kt++) acc[kt] = f32x4{0.f, 0.f, 0.f, 0.f};
      const bf16_t* arow = p.pq + (size_t)(tt * 16 + r15) * DM + hh * 256 + c * 128 + q4 * 8;
      const bf16_t* brow = p.sk_bf + ((size_t)((hh * 2 + c) * 128 + r15)) * 128 + q4 * 8;
      bf16x8 af4[4];
#pragma unroll
      for (int ks = 0; ks < 4; ks++) af4[ks] = *(const bf16x8*)(arow + ks * 32);
      bf16x8 bq0[8], bq1[8];
#pragma unroll
      for (int kt = 0; kt < 8; kt++) bq0[kt] = *(const bf16x8*)(brow + kt * 16 * 128);
#pragma unroll
      for (int kt = 0; kt < 8; kt++) bq1[kt] = *(const bf16x8*)(brow + kt * 16 * 128 + 32);
      __builtin_amdgcn_sched_barrier(0);
#pragma unroll
      for (int kt = 0; kt < 8; kt++) acc[kt] = __builtin_amdgcn_mfma_f32_16x16x32_bf16(af4[0], bq0[kt], acc[kt], 0, 0, 0);
#pragma unroll
      for (int kt = 0; kt < 8; kt++) bq0[kt] = *(const bf16x8*)(brow + kt * 16 * 128 + 64);
      __builtin_amdgcn_sched_barrier(0);
#pragma unroll
      for (int kt = 0; kt < 8; kt++) acc[kt] = __builtin_amdgcn_mfma_f32_16x16x32_bf16(af4[1], bq1[kt], acc[kt], 0, 0, 0);
#pragma unroll
      for (int kt = 0; kt < 8; kt++) bq1[kt] = *(const bf16x8*)(brow + kt * 16 * 128 + 96);
      __builtin_amdgcn_sched_barrier(0);
#pragma unroll
      for (int kt = 0; kt < 8; kt++) acc[kt] = __builtin_amdgcn_mfma_f32_16x16x32_bf16(af4[2], bq0[kt], acc[kt], 0, 0, 0);
#pragma unroll
      for (int kt = 0; kt < 8; kt++) acc[kt] = __builtin_amdgcn_mfma_f32_16x16x32_bf16(af4[3], bq1[kt], acc[kt], 0, 0, 0);
      int key[8][4];
#pragma unroll
      for (int kt = 0; kt < 8; kt++)
#pragma unroll
        for (int j = 0; j < 4; j++) key[kt][j] = (ordf(acc[kt][j]) & ~127) | (127 - (kt * 16 + r15));
#define CE_(a, b) { const int hi_ = max(key[a][j], key[b][j]); const int lo_ = min(key[a][j], key[b][j]); key[a][j] = hi_; key[b][j] = lo_; }
#pragma unroll
      for (int j = 0; j < 4; j++) {
        CE_(0, 1) CE_(2, 3) CE_(4, 5) CE_(6, 7)
        CE_(0, 2) CE_(1, 3) CE_(4, 6) CE_(5, 7)
        CE_(1, 2) CE_(5, 6)
        CE_(0, 4) CE_(1, 5) CE_(2, 6) CE_(3, 7)
        CE_(2, 4) CE_(3, 5)
        CE_(1, 2) CE_(3, 4) CE_(5, 6)
      }
#undef CE_
      int top[4] = {INT32_MIN, INT32_MIN, INT32_MIN, INT32_MIN};
#pragma unroll 1
      for (int it = 0; it < 16; it++) {
#pragma unroll
        for (int j = 0; j < 4; j++) {
          const int m = row16_allmax(key[0][j]);
          const bool own = (key[0][j] == m);
#pragma unroll
          for (int kt = 0; kt < 7; kt++) key[kt][j] = own ? key[kt + 1][j] : key[kt][j];
          key[7][j] = own ? INT32_MIN : key[7][j];
          top[j] = (r15 == it) ? m : top[j];
        }
      }
#pragma unroll
      for (int j = 0; j < 4; j++) st[c * 256 + (q4 * 4 + j) * 16 + r15] = top[j];
    }
    __builtin_amdgcn_fence(__ATOMIC_RELEASE, "wavefront");
    __builtin_amdgcn_wave_barrier();
    __builtin_amdgcn_fence(__ATOMIC_ACQUIRE, "wavefront");
    const int tl = lane >> 2, sub = lane & 3;
    int ck[13];
#pragma unroll
    for (int q = 0; q < 13; q++) {
      const int pidx = sub + 4 * q;
      const int e = tab[pidx];
      int kv = INT32_MIN;
      if (e >= 0) {
        int ka = st[tl * 16 + (e & 15)];
        int kb2 = st[256 + tl * 16 + (e >> 4)];
        float s = unordf(ka & ~127) + unordf(kb2 & ~127);
        kv = (ordf(s) & ~63) | pidx;
      }
      ck[q] = kv;
    }
    int mine[4] = {0, 0, 0, 0};
    int m0 = 0;
#pragma unroll
    for (int r = 0; r < 16; r++) {
      int m = ck[0];
#pragma unroll
      for (int q = 1; q < 13; q++) m = max(m, ck[q]);
      m = quad_allmax(m);
#pragma unroll
      for (int q = 0; q < 13; q++) ck[q] = (ck[q] == m) ? INT32_MIN : ck[q];
      if (r == 0) m0 = m;
      mine[r >> 2] = (sub == (r & 3)) ? m : mine[r >> 2];
    }
    const float mx = unordf(m0 & ~63);
    float ev[4];
    float sum = 0.f;
#pragma unroll
    for (int k = 0; k < 4; k++) { ev[k] = __expf(unordf(mine[k] & ~63) - mx); sum += ev[k]; }
    sum += __shfl_xor(sum, 1);
    sum += __shfl_xor(sum, 2);
    const float inv = 1.0f / sum;
#pragma unroll
    for (int k = 0; k < 4; k++) {
      const int e = tab[mine[k] & 63];
      const int ia = 127 - (st[tl * 16 + (e & 15)] & 127);
      const int ib = 127 - (st[256 + tl * 16 + (e >> 4)] & 127);
      const size_t o = (size_t)(tt * 16 + tl) * 128 + hh * 16 + k * 4 + sub;
      p.sel_eid[o] = ia * 128 + ib;
      p.sel_g[o] = ev[k] * inv;
    }
    __builtin_amdgcn_fence(__ATOMIC_RELEASE, "wavefront");
    __builtin_amdgcn_wave_barrier();
  }
}

struct XInfo { int wx, nwx, popidx, npop; };
__device__ __forceinline__ float dppf_add8(float v) {
  v += __int_as_float(__builtin_amdgcn_update_dpp(0, __float_as_int(v), 0xB1, 0xF, 0xF, false));
  v += __int_as_float(__builtin_amdgcn_update_dpp(0, __float_as_int(v), 0x4E, 0xF, 0xF, false));
  v += __int_as_float(__builtin_amdgcn_update_dpp(0, __float_as_int(v), 0x141, 0xF, 0xF, false));
  return v;
}
__device__ __forceinline__ float dot16_fp8v(const u32x4& r, const f32x2* h2) {
  f32x2 acc = f32x2{0.f, 0.f};
#pragma unroll
  for (int q = 0; q < 4; q++) {
    f32x2 lo = __builtin_amdgcn_cvt_pk_f32_fp8((int)r[q], false);
    f32x2 hi = __builtin_amdgcn_cvt_pk_f32_fp8((int)r[q], true);
    acc = lo * h2[q * 2] + acc;
    acc = hi * h2[q * 2 + 1] + acc;
  }
  return acc[0] + acc[1];
}
__device__ __forceinline__ void axpy16_fp8v(float w, const u32x4& r, f32x2* f2) {
  const f32x2 w2 = f32x2{w, w};
#pragma unroll
  for (int q = 0; q < 4; q++) {
    f32x2 lo = __builtin_amdgcn_cvt_pk_f32_fp8((int)r[q], false);
    f32x2 hi = __builtin_amdgcn_cvt_pk_f32_fp8((int)r[q], true);
    f2[q * 2] = w2 * lo + f2[q * 2];
    f2[q * 2 + 1] = w2 * hi + f2[q * 2 + 1];
  }
}
#define NITEM (NTOK * 128)
__device__ __forceinline__ void phase_peer_u(const Params& p, const XInfo& xi) {
  const int tid = opaque_tid(), lane = tid & 63, j8 = lane & 7, g = lane >> 3;
  int nown = 0;
  for (int ss = 0; ss < 16; ss++) nown += (((ss >> 1) % xi.npop) == xi.popidx) ? 1 : 0;
  const int nitems = nown * (NTOK / 8);
#pragma unroll 1
  for (int idx = xi.wx; idx < nitems; idx += xi.nwx) {
    const int ord = idx / (NTOK / 8), B = idx % (NTOK / 8);
    int ss = 0;
    { int c = 0; for (int q = 0; q < 16; q++) if (((q >> 1) % xi.npop) == xi.popidx) { if (c == ord) ss = q; c++; } }
    const unsigned char* ub = p.u8 + ss * 128 + j8 * 16;
    bf16_t* pdst = (bf16_t*)p.pd + (size_t)ss * NITEM;
    {
      const int tok = B * 8 + g;
      const bool valid = true;
      f32x2 h2[8];
      {
        const bf16_t* hrow = p.act2 + (size_t)tok * DM + ss * 128 + j8 * 16;
        u32x4 r0 = *(const u32x4*)(hrow), r1 = *(const u32x4*)(hrow + 8);
#pragma unroll
        for (int q = 0; q < 4; q++) {
          h2[q] = f32x2{bflo(r0[q]), bfhi(r0[q])};
          h2[4 + q] = f32x2{bflo(r1[q]), bfhi(r1[q])};
        }
      }
      const int* ep = p.sel_eid + (size_t)tok * 128;
      i32x8 e;
#pragma unroll
      for (int k = 0; k < 8; k++) e[k] = ep[k];
#pragma unroll 1
      for (int it0 = 0; it0 < 128; it0 += 8) {
        u32x4 r[8];
#pragma unroll
        for (int k = 0; k < 8; k++) r[k] = *(const u32x4*)(ub + (size_t)e[k] * DM);
        const int itn = (it0 + 8) & 127;
#pragma unroll
        for (int k = 0; k < 8; k++) e[k] = ep[itn + k];
        float d[8];
#pragma unroll
        for (int k = 0; k < 8; k++) d[k] = dppf_add8(dot16_fp8v(r[k], h2));
        float o = d[0];
#pragma unroll
        for (int k = 1; k < 8; k++) o = (j8 == k) ? d[k] : o;
        if (valid) pdst[(size_t)tok * 128 + it0 + j8] = f2bf(o);
      }
    }
  }
}
__device__ void phase_peer_w(const Params& p, int bid, int nb) {
  const int tid = opaque_tid();
  for (int i = bid * 256 + tid; i < NITEM; i += nb * 256) {
    float sacc = 0.f;
#pragma unroll
    for (int ss = 0; ss < 16; ss++) sacc += bf2f_(((const bf16_t*)p.pd)[(size_t)ss * NITEM + i]);
    const float rf = rsqrtf(p.ssq[2 * NTOK + (i >> 7)] * (1.0f / 2048.0f) + EPSV);
    p.sel_g[i] = gelu_tanh(sacc * rf * (1.0f / 256.0f)) * p.sel_g[i] * (1.0f / 16.0f);
  }
}
__device__ __forceinline__ void phase_peer_v(const Params& p, const XInfo& xi) {
  const int tid = opaque_tid(), lane = tid & 63, j8 = lane & 7, g = lane >> 3;
  int nown = 0;
  for (int ss = 0; ss < 16; ss++) nown += (((ss >> 1) % xi.npop) == xi.popidx) ? 1 : 0;
  const int nitems = nown * (NTOK / 8);
#pragma unroll 1
  for (int idx = xi.wx; idx < nitems; idx += xi.nwx) {
    const int ord = idx / (NTOK / 8), B = idx % (NTOK / 8);
    int ss = 0;
    { int c = 0; for (int q = 0; q < 16; q++) if (((q >> 1) % xi.npop) == xi.popidx) { if (c == ord) ss = q; c++; } }
    const unsigned char* vb8 = p.v8 + ss * 128 + j8 * 16;
    {
      const int tok = B * 8 + g;
      const bool valid = true;
      f32x2 f2[8];
#pragma unroll
      for (int q = 0; q < 8; q++) f2[q] = f32x2{0.f, 0.f};
      const int* ep = p.sel_eid + (size_t)tok * 128;
      const float* wp = p.sel_g + (size_t)tok * 128;
      i32x8 e; f32x8 w;
#pragma unroll
      for (int k = 0; k < 8; k++) { e[k] = ep[k]; w[k] = wp[k]; }
#pragma unroll 1
      for (int it0 = 0; it0 < 128; it0 += 8) {
        u32x4 r[8]; float wc[8];
#pragma unroll
        for (int k = 0; k < 8; k++) { r[k] = *(const u32x4*)(vb8 + (size_t)e[k] * DM); wc[k] = w[k]; }
        const int itn = (it0 + 8) & 127;
#pragma unroll
        for (int k = 0; k < 8; k++) { e[k] = ep[itn + k]; w[k] = wp[itn + k]; }
#pragma unroll
        for (int k = 0; k < 8; k++) axpy16_fp8v(wc[k], r[k], f2);
      }
      if (valid) {
        float* orow = p.out + OFF_Y + (size_t)tok * DM + ss * 128 + j8 * 16;
#pragma unroll
        for (int q = 0; q < 4; q++) {
          float4 a = *(float4*)(orow + q * 4);
          a.x += f2[q * 2][0]; a.y += f2[q * 2][1]; a.z += f2[q * 2 + 1][0]; a.w += f2[q * 2 + 1][1];
          *(float4*)(orow + q * 4) = a;
        }
      }
    }
  }
}

#define XB_TMO      128
#define XB_XCNT(j)  (256  + 64 * (j))
#define XB_XSUB(j)  (1280 + 64 * (j))
#define XB_XGEN(j)  (2304 + 64 * (j))
#define XB_TOP      3328
#define XB_TOPGEN   3392
#define XCD_BAR_WORDS 3456
#define XB_SPIN_CAP (1u << 22)
#define LAS __attribute__((address_space(3)))
__device__ __forceinline__ unsigned xb_ld(unsigned* p)              { return __hip_atomic_load(p, __ATOMIC_RELAXED, __HIP_MEMORY_SCOPE_AGENT); }
__device__ __forceinline__ unsigned xb_add(unsigned* p, unsigned v) { return __hip_atomic_fetch_add(p, v, __ATOMIC_RELAXED, __HIP_MEMORY_SCOPE_AGENT); }
__device__ __forceinline__ unsigned xb_xcc_id() { return (unsigned)__builtin_amdgcn_s_getreg((3 << 11) | 20) & 0xFu; }
#define XB_SPIN(cond, bar) do { unsigned _sp = 0; while (cond) { __builtin_amdgcn_s_sleep(24); \
    if ((++_sp & 255u) == 0u) { if (xb_ld(&(bar)[XB_TMO])) break; if (_sp > XB_SPIN_CAP) { atomicAdd(&(bar)[XB_TMO], 1u); break; } } } } while (0)
struct XcdBarrier { unsigned* bar; unsigned x; unsigned nloc, nx; };
__device__ __forceinline__ XcdBarrier xcd_barrier_post(unsigned* bar) {
  XcdBarrier b; b.bar = bar; b.x = xb_xcc_id(); b.nloc = 0u; b.nx = 0u;
  if (threadIdx.x == 0) (void)xb_add(&bar[XB_XCNT(b.x)], 1u);
  return b;
}
__device__ __forceinline__ void xcd_barrier_complete(unsigned* bar, unsigned x, unsigned& nloc, unsigned& nx) {
  const unsigned G = gridDim.x * gridDim.y * gridDim.z;
  unsigned sum, cnt, mine, sp = 0u;
  for (;;) {
    sum = 0u; cnt = 0u; mine = 0u;
#pragma unroll
    for (unsigned j = 0; j < 16; ++j) { const unsigned c = xb_ld(&bar[XB_XCNT(j)]); sum += c; cnt += (c > 0u) ? 1u : 0u; mine = (j == x) ? c : mine; }
    if (sum == G) break;
    __builtin_amdgcn_s_sleep(1);
    if ((++sp & 255u) == 0u) { if (xb_ld(&bar[XB_TMO])) break; if (sp > XB_SPIN_CAP) { atomicAdd(&bar[XB_TMO], 1u); break; } }
  }
  nloc = mine > 0u ? mine : 1u; nx = cnt > 0u ? cnt : 1u;
}
__device__ __forceinline__ void xcd_barrier(XcdBarrier& b) {
  asm volatile("s_waitcnt vmcnt(0)" ::: "memory");
  __syncthreads();
  if (threadIdx.x == 0) {
    unsigned* bar = b.bar;
    __builtin_amdgcn_s_waitcnt(0);
    unsigned nloc = b.nloc, nx = b.nx;
    if (nloc == 0u) { xcd_barrier_complete(bar, b.x, nloc, nx); b.nloc = nloc; b.nx = nx; }
    const unsigned old = xb_add(&bar[XB_XSUB(b.x)], 1u);
    const unsigned gen = old / nloc;
    if (old + 1u == (gen + 1u) * nloc) {
      __builtin_amdgcn_fence(__ATOMIC_RELEASE, "agent");
      asm volatile("s_waitcnt vmcnt(0)" ::: "memory");
      const unsigned og = xb_add(&bar[XB_TOP], 1u);
      const unsigned tg = og / nx;
      if (og + 1u == (tg + 1u) * nx) xb_add(&bar[XB_TOPGEN], 1u);
      else XB_SPIN(xb_ld(&bar[XB_TOPGEN]) == tg, bar);
      __builtin_amdgcn_fence(__ATOMIC_ACQUIRE, "agent");
      xb_add(&bar[XB_XGEN(b.x)], 1u);
      asm volatile("s_waitcnt vmcnt(0)" ::: "memory");
    } else {
      XB_SPIN(xb_ld(&bar[XB_XGEN(b.x)]) == gen, bar);
      __builtin_amdgcn_fence(__ATOMIC_ACQUIRE, "agent");
      asm volatile("s_waitcnt vmcnt(0)" ::: "memory");
    }
  }
  __syncthreads();
}

#define NPHASE 10
__device__ __forceinline__ void run_phase(const Params& p, char* smem, int ph, int bid, int nb, const XInfo& xi, const int role) {
  switch (ph) {
    case 0: phase_convert(p, smem, bid, nb); break;
    case 1: gemm_phase<0, 4>(p, smem, bid, nb, p.act, p.w_in_t, INW); break;
    case 2: phase_qkprep(p, bid, nb); phase_lru_local(p, smem, bid, nb); break;
    case 3: phase_attn(p, smem, bid, nb); phase_lru_apply(p, bid, nb); break;
    case 4: gemm_phase<1, 3>(p, smem, bid, nb, p.act, p.w_out_t, DM); break;
    case 5: gemm_phase<2, 3>(p, smem, bid, nb, p.act2, p.w_pq_t, DM); break;
    case 6:
      if (role == 0) {
        convert_table_fp8(p.peer_u, p.u8, 256.0f, bid, nb, p.g_ffn);
        convert_table_fp8(p.peer_v, p.v8, 16.0f, bid, nb, nullptr);
        copy_cache_rows(p, bid, nb);
        phase_peer_select(p, smem, bid, nb);
      } else {
        phase_peer_select(p, smem, bid, nb);
        convert_table_fp8(p.peer_u, p.u8, 256.0f, bid, nb, p.g_ffn);
        convert_table_fp8(p.peer_v, p.v8, 16.0f, bid, nb, nullptr);
        copy_cache_rows(p, bid, nb);
      }
      break;
    case 7: phase_peer_u(p, xi); break;
    case 8: phase_peer_w(p, bid, nb); break;
    case 9: phase_peer_v(p, xi); break;
  }
}

#if ONE_LAUNCH
__global__ void __launch_bounds__(256, 2) k_mega(Params p) {
  __shared__ __attribute__((aligned(16))) char smem[65536];
  __shared__ int s_rank[4];
  XcdBarrier xb; xb.bar = p.bar; xb.x = xb_xcc_id(); xb.nloc = 0u; xb.nx = 0u;
  if (threadIdx.x == 0) {
    s_rank[0] = (int)xb_add(&p.bar[XB_XCNT(xb.x)], 1u);
    const unsigned hwid = (unsigned)__builtin_amdgcn_s_getreg((31 << 11) | 4);
    const unsigned slot = (hwid >> 8) & 0xFFu;
    s_rank[1] = (int)(xb_add(&p.bar[XCD_BAR_WORDS + xb.x * 256 + slot], 1u) & 1u);
  }
  __syncthreads();
  const int rank = s_rank[0];
  const int role = (blockIdx.x >= gridDim.x / 2) ? 1 : 0;
  XInfo xi{0, 0, 0, 1};
#pragma unroll 1
  for (int ph = 0; ph < NPHASE; ph++) {
    if (ph == 7) {
      int npop = 0, popidx = 0, nloc = 1;
      for (int j = 0; j < 16; j++) {
        const int c = (int)xb_ld(&p.bar[XB_XCNT(j)]);
        if (c > 0) { if (j == (int)xb.x) { popidx = npop; nloc = c; } npop++; }
      }
      xi.wx = rank * 4 + (threadIdx.x >> 6); xi.nwx = nloc * 4; xi.popidx = popidx; xi.npop = npop;
    }
    run_phase(p, smem, ph, blockIdx.x, gridDim.x, xi, role);
    if (ph + 1 < NPHASE) xcd_barrier(xb);
  }
}
#endif

extern "C" void kernel_launch(void* const* d_in, const int* in_sizes, int n_in, void* d_out, int out_size, void* d_ws,
                              size_t ws_size, hipStream_t stream) {
  Params p{};
  const float* const* in = (const float* const*)d_in;
  p.x_prompt = in[0]; p.x_sample = in[1]; p.cache_k = in[2]; p.cache_v = in[3]; p.state_conv = in[4]; p.state_h = in[5];
  p.g_mix = in[6]; p.w_in = in[7]; p.g_q = in[8]; p.g_k = in[9]; p.sinks = in[10]; p.conv_w = in[11]; p.conv_b = in[12];
  p.w_a = in[13]; p.b_a = in[14]; p.w_x = in[15]; p.b_x = in[16]; p.lam = in[17]; p.g_ao = in[18]; p.g_lo = in[19];
  p.w_out = in[20]; p.g_ffn = in[21]; p.w_pq = in[22]; p.sub_keys = in[23]; p.peer_u = in[24]; p.peer_v = in[25];
  p.out = (float*)d_out;
  char* w = (char*)d_ws;
  size_t off = 0;
  auto take = [&](size_t bytes) { char* r = w + off; off += (bytes + 255) & ~(size_t)255; return r; };
  p.w_in_t = (bf16_t*)take((size_t)INW * DM * 2);
  p.w_out_t = (bf16_t*)take((size_t)DM * DM * 2);
  p.w_pq_t = (bf16_t*)take((size_t)DM * DM * 2);
  p.sk_bf = (bf16_t*)take((size_t)262144 * 2);
  p.wg_t = (bf16_t*)take((size_t)131072 * 2);
  p.u8 = (unsigned char*)take((size_t)16384 * DM);
  p.v8 = (unsigned char*)take((size_t)16384 * DM);
  p.act = (bf16_t*)take((size_t)NTOK * DM * 2);
  p.z = (float*)take((size_t)NTOK * INW * 4);
  p.zb = (bf16_t*)p.z;
  p.qb = (bf16_t*)take((size_t)NTOK * 1024 * 2);
  p.kb = (bf16_t*)take((size_t)NTOK * 256 * 2);
  p.vb = (bf16_t*)take((size_t)NTOK * 256 * 2);
  p.hloc = (float*)take((size_t)NTOK * 1024 * 4);
  p.pc = (float*)take((size_t)NTOK * 1024 * 4);
  p.chA = (float*)take((size_t)2 * 64 * 1024 * 4);
  p.chU = (float*)take((size_t)2 * 64 * 1024 * 4);
  p.mixraw = (float*)take((size_t)NTOK * DM * 4);
  p.act2 = (bf16_t*)p.mixraw;
  p.ssq = (float*)take((size_t)3 * NTOK * 4);
  p.bar = (unsigned*)take((size_t)(XCD_BAR_WORDS + 16 * 256) * 4);
  p.pd = p.hloc;
  p.pq = (bf16_t*)p.z;
  p.sel_eid = (int*)((char*)p.z + (size_t)NTOK * DM * 2);
  p.sel_g = (float*)((char*)p.z + (size_t)NTOK * DM * 2 + (size_t)NTOK * 128 * 4);
  if (off > ws_size) { fprintf(stderr, "workspace too small: need %zu have %zu\n", off, ws_size); return; }

  static int grid_blocks = 0;
  if (!grid_blocks) {
    int dev = 0, cus = 0, per_cu = 0;
    (void)hipGetDevice(&dev);
    (void)hipDeviceGetAttribute(&cus, hipDeviceAttributeMultiprocessorCount, dev);
#if ONE_LAUNCH
    (void)hipOccupancyMaxActiveBlocksPerMultiprocessor(&per_cu, k_mega, 256, 0);
#endif
    if (per_cu > 2) per_cu = 2;
    if (per_cu < 1) per_cu = 1;
    grid_blocks = cus * per_cu;
  }
#if ONE_LAUNCH
  (void)hipMemsetAsync(p.bar, 0, (size_t)(XCD_BAR_WORDS + 16 * 256) * 4, stream);
  void* args[] = {&p};
  hipError_t e = hipLaunchCooperativeKernel((void*)k_mega, dim3(grid_blocks), dim3(256), args, 0, stream);
  if (e != hipSuccess) fprintf(stderr, "cooperative launch failed: %s (grid %d)\n", hipGetErrorString(e), grid_blocks);
#endif
}
```

```cpp
#include <hip/hip_runtime.h>
#include <hip/hip_cooperative_groups.h>
#include <cstdio>
#include <cstdint>
namespace cg = cooperative_groups;

#ifndef ONE_LAUNCH
#define ONE_LAUNCH 1
#endif

typedef unsigned short bf16_t;
using bf16x8 = __attribute__((ext_vector_type(8))) short;
using f32x4 = __attribute__((ext_vector_type(4))) float;
using f32x2 = __attribute__((ext_vector_type(2))) float;
using u32x4 = __attribute__((ext_vector_type(4))) unsigned;
using i32x8 = __attribute__((ext_vector_type(8))) int;
using f32x8 = __attribute__((ext_vector_type(8))) float;

#define NTOK 9216
#define NPROMPT 8192
#define DM 2048
#define INW 3584
#define EPSV 1e-6f

struct Params {
  const float *x_prompt, *x_sample, *cache_k, *cache_v, *state_conv, *state_h;
  const float *g_mix, *w_in, *g_q, *g_k, *sinks, *conv_w, *conv_b, *w_a, *b_a, *w_x, *b_x, *lam;
  const float *g_ao, *g_lo, *w_out, *g_ffn, *w_pq, *sub_keys, *peer_u, *peer_v;
  float* out;
  bf16_t *w_in_t, *w_out_t, *w_pq_t, *wg_t, *sk_bf, *act, *qb, *kb, *vb, *pq;
  float *z, *hloc, *pc, *chA, *chU, *mixraw, *sel_g;
  int* sel_eid;
  float* pd;
  bf16_t* zb;
  float* ssq;
  bf16_t* act2;
  unsigned char *u8, *v8;
  unsigned* bar;
};

#define OFF_Y 0
#define OFF_KP 18874368
#define OFF_VP 18939904
#define OFF_CP 19005440
#define OFF_HP 19011584
#define OFF_KS 19013632
#define OFF_VS 23207936
#define OFF_CS 27402240
#define OFF_HS 27795456

__device__ __forceinline__ int opaque_tid() { int t = threadIdx.x; asm volatile("" : "+v"(t)); return t; }
__device__ __forceinline__ bf16_t f2bf(float f) {
  unsigned u = __float_as_uint(f);
  u += 0x7FFFu + ((u >> 16) & 1u);
  return (bf16_t)(u >> 16);
}
__device__ __forceinline__ unsigned pack2bf(float a, float b) {
  return (unsigned)f2bf(a) | ((unsigned)f2bf(b) << 16);
}
__device__ __forceinline__ float bf2f_(bf16_t b) { return __uint_as_float((unsigned)b << 16); }
__device__ __forceinline__ float bflo(unsigned u) { return __uint_as_float(u << 16); }
__device__ __forceinline__ float bfhi(unsigned u) { return __uint_as_float(u & 0xFFFF0000u); }

__device__ __forceinline__ float wave_sum(float v) {
#pragma unroll
  for (int o = 32; o > 0; o >>= 1) v += __shfl_xor(v, o);
  return v;
}
__device__ __forceinline__ float row16_sum(float v) {
  v += __int_as_float(__builtin_amdgcn_update_dpp(0, __float_as_int(v), 0xB1, 0xF, 0xF, false));
  v += __int_as_float(__builtin_amdgcn_update_dpp(0, __float_as_int(v), 0x4E, 0xF, 0xF, false));
  v += __int_as_float(__builtin_amdgcn_update_dpp(0, __float_as_int(v), 0x141, 0xF, 0xF, false));
  v += __int_as_float(__builtin_amdgcn_update_dpp(0, __float_as_int(v), 0x140, 0xF, 0xF, false));
  return v;
}
__device__ __forceinline__ float gelu_tanh(float x) {
  float y = 0.7978845608028654f * (x + 0.044715f * x * x * x);
  float e = __expf(2.0f * y);
  float t = 1.0f - 2.0f / (e + 1.0f);
  return 0.5f * x * (1.0f + t);
}
__device__ __forceinline__ float sigmoidf_(float x) { return 1.0f / (1.0f + __expf(-x)); }

__device__ __forceinline__ const float* xrow(const Params& p, int tok) {
  return tok < NPROMPT ? p.x_prompt + (size_t)tok * DM : p.x_sample + (size_t)(tok - NPROMPT) * DM;
}

__device__ __forceinline__ void rms_row_to_bf16(const float* __restrict__ src, const float* __restrict__ g,
                                                bf16_t* __restrict__ dst, int lane) {
  float4 v[8];
  float ss = 0.f;
#pragma unroll
  for (int i = 0; i < 8; i++) {
    v[i] = *(const float4*)(src + i * 256 + lane * 4);
    ss += v[i].x * v[i].x + v[i].y * v[i].y + v[i].z * v[i].z + v[i].w * v[i].w;
  }
  ss = wave_sum(ss);
  float r = rsqrtf(ss * (1.0f / DM) + EPSV);
#pragma unroll
  for (int i = 0; i < 8; i++) {
    float4 gg = *(const float4*)(g + i * 256 + lane * 4);
    uint2 o;
    o.x = pack2bf(v[i].x * r * gg.x, v[i].y * r * gg.y);
    o.y = pack2bf(v[i].z * r * gg.z, v[i].w * r * gg.w);
    *(uint2*)(dst + i * 256 + lane * 4) = o;
  }
}

__device__ void convert_table_fp8(const float* __restrict__ src, unsigned char* __restrict__ dst, const float sc, int worker, int nworkers, const float* __restrict__ colg) {
  const int tid = opaque_tid();
  const size_t units = (size_t)16384 * 2048 / 16;
  const size_t stride = (size_t)nworkers * 256;
  for (size_t i = (size_t)worker * 256 + tid; i < units; i += 2 * stride) {
    const size_t j1 = (i + stride < units) ? i + stride : i;
    f32x4 a0[4], a1[4];
#pragma unroll
    for (int q = 0; q < 4; q++) a0[q] = __builtin_nontemporal_load((const f32x4*)(src + i * 16 + q * 4));
#pragma unroll
    for (int q = 0; q < 4; q++) a1[q] = __builtin_nontemporal_load((const f32x4*)(src + j1 * 16 + q * 4));
    if (colg) {
#pragma unroll
      for (int q = 0; q < 4; q++) {
        const f32x4 g0 = *(const f32x4*)(colg + ((i * 16 + q * 4) & 2047));
        const f32x4 g1 = *(const f32x4*)(colg + ((j1 * 16 + q * 4) & 2047));
        a0[q] *= g0; a1[q] *= g1;
      }
    }
    u32x4 o0, o1;
#pragma unroll
    for (int q = 0; q < 4; q++) {
      int w = 0;
      w = __builtin_amdgcn_cvt_pk_fp8_f32(fminf(fmaxf(a0[q][0] * sc, -448.f), 448.f), fminf(fmaxf(a0[q][1] * sc, -448.f), 448.f), w, false);
      w = __builtin_amdgcn_cvt_pk_fp8_f32(fminf(fmaxf(a0[q][2] * sc, -448.f), 448.f), fminf(fmaxf(a0[q][3] * sc, -448.f), 448.f), w, true);
      o0[q] = (unsigned)w;
      int w1 = 0;
      w1 = __builtin_amdgcn_cvt_pk_fp8_f32(fminf(fmaxf(a1[q][0] * sc, -448.f), 448.f), fminf(fmaxf(a1[q][1] * sc, -448.f), 448.f), w1, false);
      w1 = __builtin_amdgcn_cvt_pk_fp8_f32(fminf(fmaxf(a1[q][2] * sc, -448.f), 448.f), fminf(fmaxf(a1[q][3] * sc, -448.f), 448.f), w1, true);
      o1[q] = (unsigned)w1;
    }
    *(u32x4*)(dst + i * 16) = o0;
    *(u32x4*)(dst + j1 * 16) = o1;
  }
}

__device__ void copy_cache_rows(const Params& p, int bid, int nb) {
  const int tid = opaque_tid();
  {
    const int per_b = 120 * 256 / 4;
    const int half = 128 * per_b, quarter = half / 2;
    for (int i = bid * 256 + tid; i < quarter; i += nb * 256) {
      const int j0 = i, j1 = i + quarter;
      const int b0 = j0 / per_b, r0 = j0 % per_b, b1 = j1 / per_b, r1 = j1 % per_b;
      const size_t s0 = (size_t)b0 * 32768 + 8 * 256 + r0 * 4, s1 = (size_t)b1 * 32768 + 8 * 256 + r1 * 4;
      const size_t d0 = (size_t)b0 * 32768 + r0 * 4, d1 = (size_t)b1 * 32768 + r1 * 4;
      const f32x4 v0 = *(const f32x4*)(p.cache_k + s0);
      const f32x4 v1 = *(const f32x4*)(p.cache_k + s1);
      const f32x4 v2 = *(const f32x4*)(p.cache_v + s0);
      const f32x4 v3 = *(const f32x4*)(p.cache_v + s1);
      *(f32x4*)(p.out + OFF_KS + d0) = v0;
      *(f32x4*)(p.out + OFF_KS + d1) = v1;
      *(f32x4*)(p.out + OFF_VS + d0) = v2;
      *(f32x4*)(p.out + OFF_VS + d1) = v3;
    }
  }
}

__device__ void phase_convert(const Params& p, char* smem, int bid, int nb) {
  const int tid = opaque_tid(), lane = tid & 63, wave = tid >> 6;
  float* tile = (float*)smem;
  const int T_IN = 32 * 56, T_OUT = 32 * 32, T_PQ = 32 * 32;
  for (int t = bid; t < T_IN + T_OUT + T_PQ; t += nb) {
    const float* W; bf16_t* Wt; int N; int tt = t;
    int gsel;
    if (tt < T_IN) { W = p.w_in; Wt = p.w_in_t; N = INW; gsel = 0; }
    else if (tt < T_IN + T_OUT) { tt -= T_IN; W = p.w_out; Wt = p.w_out_t; N = DM; gsel = 1; }
    else { tt -= T_IN + T_OUT; W = p.w_pq; Wt = p.w_pq_t; N = DM; gsel = 2; }
    const int ntn = N / 64;
    const int kt = tt / ntn, nt = tt % ntn;
    {
      const int krow = tid >> 4, nq = tid & 15;
      float4 v[4];
#pragma unroll
      for (int i = 0; i < 4; i++) v[i] = *(const float4*)(W + (size_t)(kt * 64 + krow + 16 * i) * N + nt * 64 + nq * 4);
#pragma unroll
      for (int i = 0; i < 4; i++) {
        const int kk = kt * 64 + krow + 16 * i;
        const float gk = (gsel == 0) ? 1.0f : (gsel == 2) ? p.g_ffn[kk] : (kk < 1024 ? p.g_ao[kk] : p.g_lo[kk - 1024]);
        float* tp = tile + (krow + 16 * i) * 65 + nq * 4;
        tp[0] = v[i].x * gk; tp[1] = v[i].y * gk; tp[2] = v[i].z * gk; tp[3] = v[i].w * gk;
      }
    }
    __syncthreads();
    {
      const int n = tid >> 2, kq = tid & 3;
      u32x4 o0, o1;
#pragma unroll
      for (int e = 0; e < 4; e++) {
        o0[e] = pack2bf(tile[(kq * 16 + 2 * e) * 65 + n], tile[(kq * 16 + 2 * e + 1) * 65 + n]);
        o1[e] = pack2bf(tile[(kq * 16 + 8 + 2 * e) * 65 + n], tile[(kq * 16 + 8 + 2 * e + 1) * 65 + n]);
      }
      bf16_t* wp = Wt + (size_t)(nt * 64 + n) * DM + kt * 64 + kq * 16;
      *(u32x4*)(wp) = o0;
      *(u32x4*)(wp + 8) = o1;
    }
    __syncthreads();
  }
  {
    for (int i = bid * 256 + tid; i < 262144 / 8; i += nb * 256) {
      float4 a = *(const float4*)(p.sub_keys + (size_t)i * 8);
      float4 b = *(const float4*)(p.sub_keys + (size_t)i * 8 + 4);
      uint4 o;
      o.x = pack2bf(a.x, a.y); o.y = pack2bf(a.z, a.w); o.z = pack2bf(b.x, b.y); o.w = pack2bf(b.z, b.w);
      *(uint4*)(p.sk_bf + (size_t)i * 8) = o;
    }
  }
  for (int i = bid * 256 + tid; i < 3 * NTOK; i += nb * 256) p.ssq[i] = 0.f;
  for (int i = bid * 256 + tid; i < 131072; i += nb * 256) {
    const int d = i & 63, e = (i >> 6) & 63, n = (i >> 12) & 15, g = i >> 16;
    const float* W = g ? p.w_x : p.w_a;
    p.wg_t[i] = f2bf(W[(size_t)(n * 64 + d) * 64 + e]);
  }
  for (int tok = bid * 4 + wave; tok < NTOK; tok += nb * 4)
    rms_row_to_bf16(xrow(p, tok), p.g_mix, p.act + (size_t)tok * DM, lane);
}

#define GEMM_GLOAD(S, koff)                                          \
  S##a0 = *(const u32x4*)(ga + (koff));                              \
  S##a1 = *(const u32x4*)(ga + (koff) + (size_t)32 * DM);            \
  S##a2 = *(const u32x4*)(ga + (koff) + (size_t)64 * DM);            \
  if (MI == 4) S##a3 = *(const u32x4*)(ga + (koff) + (size_t)96 * DM); \
  S##b0 = *(const u32x4*)(gb + (koff));                              \
  S##b1 = *(const u32x4*)(gb + (koff) + (size_t)32 * DM);            \
  S##b2 = *(const u32x4*)(gb + (koff) + (size_t)64 * DM);            \
  S##b3 = *(const u32x4*)(gb + (koff) + (size_t)96 * DM);
#define GEMM_LSTORE(S, boff)                                         \
  *(u32x4*)(sA + (boff) + loff) = S##a0;                             \
  *(u32x4*)(sA + (boff) + loff + 32 * 64) = S##a1;                   \
  *(u32x4*)(sA + (boff) + loff + 64 * 64) = S##a2;                   \
  if (MI == 4) *(u32x4*)(sA + (boff) + loff + 96 * 64) = S##a3;      \
  *(u32x4*)(sB + (boff) + loff) = S##b0;                             \
  *(u32x4*)(sB + (boff) + loff + 32 * 64) = S##b1;                   \
  *(u32x4*)(sB + (boff) + loff + 64 * 64) = S##b2;                   \
  *(u32x4*)(sB + (boff) + loff + 96 * 64) = S##b3;
#define GEMM_COMPUTE(cA, cB)                                                                      \
  _Pragma("unroll") for (int ks = 0; ks < 2; ks++) {                                               \
    bf16x8 af[MI], bfr[4];                                                                         \
    const int kc = ks * 4 + (lane >> 4);                                                           \
    _Pragma("unroll") for (int mi = 0; mi < MI; mi++) {                                            \
      const int row = wm * (MI * 16) + mi * 16 + (lane & 15);                                      \
      af[mi] = *(const bf16x8*)((cA) + row * 64 + ((kc ^ (row & 7)) * 8));                         \
    }                                                                                              \
    _Pragma("unroll") for (int ni = 0; ni < 4; ni++) {                                             \
      const int row = wn * 64 + ni * 16 + (lane & 15);                                             \
      bfr[ni] = *(const bf16x8*)((cB) + row * 64 + ((kc ^ (row & 7)) * 8));                        \
    }                                                                                              \
    _Pragma("unroll") for (int mi = 0; mi < MI; mi++)                                              \
      _Pragma("unroll") for (int ni = 0; ni < 4; ni++)                                             \
        acc[mi][ni] = __builtin_amdgcn_mfma_f32_16x16x32_bf16(af[mi], bfr[ni], acc[mi][ni], 0, 0, 0); \
    __builtin_amdgcn_iglp_opt(0);                                                                  \
  }
template <int MODE, int MI>
__device__ void gemm_phase(const Params& p, char* smem, int bid, int nb, const bf16_t* __restrict__ A,
                           const bf16_t* __restrict__ Bt, const int N) {
  constexpr int K = DM;
  bf16_t* sA = (bf16_t*)smem;
  bf16_t* sB = sA + 2 * 8192;
  const int tid = opaque_tid(), lane = tid & 63, wave = tid >> 6;
  const int wm = wave >> 1, wn = wave & 1;
  const int ntn = N / 128;
  constexpr int BM = MI * 32;
  const int ntiles = (NTOK / BM) * ntn;
  const int lrow = tid >> 3, lkc = tid & 7;
  const u32x4 z4_ = u32x4{0, 0, 0, 0};
  u32x4 p0a0 = z4_, p0a1 = z4_, p0a2 = z4_, p0a3 = z4_, p0b0 = z4_, p0b1 = z4_, p0b2 = z4_, p0b3 = z4_;
  u32x4 p1a0 = z4_, p1a1 = z4_, p1a2 = z4_, p1a3 = z4_, p1b0 = z4_, p1b1 = z4_, p1b2 = z4_, p1b3 = z4_;
  const int loff = lrow * 64 + ((lkc ^ (lrow & 7)) * 8);
  constexpr int KT = K / 64;
  const bf16_t* ga = A;
  const bf16_t* gb = Bt;
  if (bid < ntiles) {
    ga = A + (size_t)((bid / ntn) * BM + lrow) * K + lkc * 8;
    gb = Bt + (size_t)((bid % ntn) * 128 + lrow) * K + lkc * 8;
    GEMM_GLOAD(p0, 0)
    GEMM_GLOAD(p1, 64)
  }
  for (int t = bid; t < ntiles; t += nb) {
    const int mt = t / ntn, nt = t % ntn;
    const int m0 = mt * BM, n0 = nt * 128;
    f32x4 acc[MI][4];
#pragma unroll
    for (int i = 0; i < MI; i++)
#pragma unroll
      for (int j = 0; j < 4; j++) acc[i][j] = f32x4{0.f, 0.f, 0.f, 0.f};
    GEMM_LSTORE(p0, 0)
    __syncthreads();
#pragma unroll 1
    for (int kt = 0; kt < KT; kt += 2) {
      if (MODE == 1 && kt == KT / 2) {
#pragma unroll
        for (int mi = 0; mi < MI; mi++)
#pragma unroll
          for (int j = 0; j < 4; j++) {
            const int row = m0 + wm * (MI * 16) + mi * 16 + (lane >> 4) * 4 + j;
            const float ra = rsqrtf(p.ssq[row] * (1.0f / 1024.0f) + EPSV);
            const float rl = rsqrtf(p.ssq[NTOK + row] * (1.0f / 1024.0f) + EPSV);
            const float ratio = ra / rl;
#pragma unroll
            for (int ni = 0; ni < 4; ni++) acc[mi][ni][j] *= ratio;
          }
      }
      { const int k2 = min(kt + 2, KT - 1) * 64; GEMM_GLOAD(p0, k2) }
      GEMM_COMPUTE(sA, sB)
      GEMM_LSTORE(p1, 8192)
      __syncthreads();
      { const int k3 = min(kt + 3, KT - 1) * 64; GEMM_GLOAD(p1, k3) }
      GEMM_COMPUTE(sA + 8192, sB + 8192)
      GEMM_LSTORE(p0, 0)
      __syncthreads();
    }
    {
      const int tn = t + nb;
      if (tn < ntiles) {
        ga = A + (size_t)((tn / ntn) * BM + lrow) * K + lkc * 8;
        gb = Bt + (size_t)((tn % ntn) * 128 + lrow) * K + lkc * 8;
        GEMM_GLOAD(p0, 0)
        GEMM_GLOAD(p1, 64)
      }
    }
#pragma unroll
    for (int mi = 0; mi < MI; mi++)
#pragma unroll
      for (int j = 0; j < 4; j++) {
        const int row = m0 + wm * (MI * 16) + mi * 16 + (lane >> 4) * 4 + j;
        float rs = 1.0f, sq = 0.f;
        if (MODE == 1) rs = rsqrtf(p.ssq[NTOK + row] * (1.0f / 1024.0f) + EPSV);
        if (MODE == 2) rs = rsqrtf(p.ssq[2 * NTOK + row] * (1.0f / 2048.0f) + EPSV);
#pragma unroll
        for (int ni = 0; ni < 4; ni++) {
          const int col = n0 + wn * 64 + ni * 16 + (lane & 15);
          const float v = acc[mi][ni][j] * rs;
          if (MODE == 0) p.zb[(size_t)row * INW + col] = f2bf(v);
          else if (MODE == 1) {
            const float x1 = xrow(p, row)[col] + v;
            p.out[OFF_Y + (size_t)row * DM + col] = x1;
            p.act2[(size_t)row * DM + col] = f2bf(x1);
            sq += x1 * x1;
          } else p.pq[(size_t)row * DM + col] = f2bf(v);
        }
        if (MODE == 1) {
          sq = row16_sum(sq);
          if ((lane & 15) == 0) atomicAdd(&p.ssq[2 * NTOK + row], sq);
        }
      }
  }
  if (false && MODE != 0) {
    const int rem = ntiles % nb;
    if (rem == 0 || bid >= rem) {
      const int worker = rem ? bid - rem : bid, nworkers = rem ? nb - rem : nb;
      if (MODE == 1) convert_table_fp8(p.peer_u, p.u8, 256.0f, worker, nworkers, p.g_ffn);
      else convert_table_fp8(p.peer_v, p.v8, 16.0f, worker, nworkers, nullptr);
    }
  }
}

__device__ void phase_qkprep(const Params& p, int bid, int nb) {
  const int tid = opaque_tid(), lane = tid & 63, wave = tid >> 6;
  const float gq = p.g_q[lane], gk = p.g_k[lane];
  const float inv = expf(-9.210340371976184f * (float)(lane & 31) * (2.0f / 64.0f));
  for (int tok = bid * 4 + wave; tok < NTOK; tok += nb * 4) {
    const bool prompt = tok < NPROMPT;
    const int b = prompt ? (tok >> 12) : ((tok - NPROMPT) >> 3);
    const int t = prompt ? (tok & 4095) : ((tok - NPROMPT) & 7);
    const float pos = prompt ? (float)t : (float)(8192 + t);
    float sn, cs;
    sincosf(pos * inv, &sn, &cs);
    const bf16_t* zr = p.zb + (size_t)tok * INW;
    float v[20], vv[4], ss[20];
#pragma unroll
    for (int h = 0; h < 20; h++) v[h] = bf2f_(zr[h * 64 + lane]);
#pragma unroll
    for (int kh = 0; kh < 4; kh++) vv[kh] = bf2f_(zr[1280 + kh * 64 + lane]);
#pragma unroll
    for (int h = 0; h < 20; h++) ss[h] = v[h] * v[h];
#pragma unroll
    for (int o = 32; o > 0; o >>= 1)
#pragma unroll
      for (int h = 0; h < 20; h++) ss[h] += __shfl_xor(ss[h], o);
#pragma unroll
    for (int h = 0; h < 20; h++) {
      const float y = v[h] * rsqrtf(ss[h] * (1.0f / 64.0f) + EPSV) * (h < 16 ? gq : gk);
      const float o = __shfl_xor(y, 32);
      const float r = (lane < 32) ? (y * cs - o * sn) : (y * cs + o * sn);
      if (h < 16) {
        p.qb[(size_t)tok * 1024 + h * 64 + lane] = f2bf(r);
      } else {
        const int kh = h - 16;
        p.kb[(size_t)tok * 256 + kh * 64 + lane] = f2bf(r);
        p.vb[(size_t)tok * 256 + kh * 64 + lane] = f2bf(vv[kh]);
        if (prompt) {
          if (t >= 4096 - 128) {
            const size_t o2 = ((size_t)b * 128 + (t - 3968)) * 256 + kh * 64 + lane;
            p.out[OFF_KP + o2] = r;
            p.out[OFF_VP + o2] = vv[kh];
          }
        } else {
          const size_t o2 = ((size_t)b * 128 + 120 + t) * 256 + kh * 64 + lane;
          p.out[OFF_KS + o2] = r;
          p.out[OFF_VS + o2] = vv[kh];
        }
      }
    }
  }
}

#define LRS 68
__device__ void phase_lru_local(const Params& p, char* smem, int bid, int nb) {
  const int tid = opaque_tid(), lane = tid & 63, wave = tid >> 6;
  const int r15 = lane & 15, q4 = lane >> 4;
  char* wb = smem + wave * (2048 + 2 * 16 * LRS * 4);
  bf16_t* xcb = (bf16_t*)wb;
  float* xcf = (float*)(wb + 2048);
  float* ga = xcf + 16 * LRS;
  for (int u = bid * 4 + wave; u < 4096; u += nb * 4) {
    const bool prompt = u < 2048;
    const int n = u & 15;
    const int ch = n * 64 + lane;
    int b, chunk, tok0, T;
    if (prompt) { b = u >> 10; chunk = (u >> 4) & 63; tok0 = b * 4096 + chunk * 64; T = 64; }
    else { b = (u - 2048) >> 4; chunk = 0; tok0 = NPROMPT + b * 8; T = 8; }
    bf16x8 Bf[2][4][2];
#pragma unroll
    for (int g = 0; g < 2; g++)
#pragma unroll
      for (int nt = 0; nt < 4; nt++)
#pragma unroll
        for (int ks = 0; ks < 2; ks++)
          Bf[g][nt][ks] = *(const bf16x8*)(p.wg_t + ((size_t)((g * 16 + n) * 64 + nt * 16 + r15)) * 64 + ks * 32 + q4 * 8);
    float bav[4], bxv[4], spv[4];
#pragma unroll
    for (int nt = 0; nt < 4; nt++) {
      const int e = n * 64 + nt * 16 + r15;
      bav[nt] = p.b_a[e]; bxv[nt] = p.b_x[e];
      spv[nt] = -8.0f * log1pf(expf(-p.lam[e]));
    }
    const float cb = p.conv_b[ch];
    const float cw0 = p.conv_w[ch], cw1 = p.conv_w[1024 + ch], cw2 = p.conv_w[2048 + ch], cw3 = p.conv_w[3072 + ch];
    float xm3 = 0.f, xm2 = 0.f, xm1 = 0.f, h = 0.f, P = 1.f;
    if (!prompt) {
      xm3 = p.state_conv[((size_t)b * 3 + 0) * 1024 + ch];
      xm2 = p.state_conv[((size_t)b * 3 + 1) * 1024 + ch];
      xm1 = p.state_conv[((size_t)b * 3 + 2) * 1024 + ch];
      h = p.state_h[(size_t)b * 1024 + ch];
    } else if (chunk > 0) {
      xm3 = bf2f_(p.zb[(size_t)(tok0 - 3) * INW + 1536 + ch]);
      xm2 = bf2f_(p.zb[(size_t)(tok0 - 2) * INW + 1536 + ch]);
      xm1 = bf2f_(p.zb[(size_t)(tok0 - 1) * INW + 1536 + ch]);
    }
#pragma unroll 1
    for (int t0 = 0; t0 < T; t0 += 16) {
      const int nv = min(16, T - t0);
      float xr[16];
#pragma unroll
      for (int i = 0; i < 16; i++) xr[i] = (i < nv) ? bf2f_(p.zb[(size_t)(tok0 + t0 + i) * INW + 1536 + ch]) : 0.f;
#pragma unroll
      for (int i = 0; i < 16; i++) {
        const float xc = cw0 * xm3 + cw1 * xm2 + cw2 * xm1 + cw3 * xr[i] + cb;
        if (i < nv) { xm3 = xm2; xm2 = xm1; xm1 = xr[i]; }
        xcf[i * LRS + lane] = xc;
        xcb[i * 64 + (((lane >> 3) ^ (i & 7)) * 8) + (lane & 7)] = f2bf(xc);
      }
      __builtin_amdgcn_fence(__ATOMIC_RELEASE, "wavefront");
      __builtin_amdgcn_wave_barrier();
      __builtin_amdgcn_fence(__ATOMIC_ACQUIRE, "wavefront");
      const bf16x8 A0 = *(const bf16x8*)(xcb + r15 * 64 + ((q4 ^ (r15 & 7)) * 8));
      const bf16x8 A1 = *(const bf16x8*)(xcb + r15 * 64 + (((4 + q4) ^ (r15 & 7)) * 8));
#pragma unroll
      for (int nt = 0; nt < 4; nt++) {
        f32x4 aa = f32x4{0.f, 0.f, 0.f, 0.f}, ax = f32x4{0.f, 0.f, 0.f, 0.f};
        aa = __builtin_amdgcn_mfma_f32_16x16x32_bf16(A0, Bf[0][nt][0], aa, 0, 0, 0);
        aa = __builtin_amdgcn_mfma_f32_16x16x32_bf16(A1, Bf[0][nt][1], aa, 0, 0, 0);
        ax = __builtin_amdgcn_mfma_f32_16x16x32_bf16(A0, Bf[1][nt][0], ax, 0, 0, 0);
        ax = __builtin_amdgcn_mfma_f32_16x16x32_bf16(A1, Bf[1][nt][1], ax, 0, 0, 0);
#pragma unroll
        for (int j = 0; j < 4; j++) {
          const int o = (q4 * 4 + j) * LRS + nt * 16 + r15;
          const float r = sigmoidf_(aa[j] + bav[nt]);
          const float ig = sigmoidf_(ax[j] + bxv[nt]);
          const float la = r * spv[nt];
          const float a = __expf(la);
          const float x2 = 2.0f * la;
          const float om = (x2 > -0.02f) ? (-x2 * (1.0f + x2 * (0.5f + x2 * (1.0f / 6.0f)))) : (1.0f - a * a);
          const float uu = sqrtf(om) * ig * xcf[o];
          ga[o] = a;
          xcf[o] = uu;
        }
      }
      __builtin_amdgcn_fence(__ATOMIC_RELEASE, "wavefront");
      __builtin_amdgcn_wave_barrier();
      __builtin_amdgcn_fence(__ATOMIC_ACQUIRE, "wavefront");
#pragma unroll
      for (int i = 0; i < 16; i++) {
        if (i < nv) {
          const float a = ga[i * LRS + lane];
          const float uu = xcf[i * LRS + lane];
          h = a * h + uu;
          P *= a;
          const size_t o = (size_t)(tok0 + t0 + i) * 1024 + ch;
          ((bf16_t*)p.hloc)[o] = f2bf(h);
          ((bf16_t*)p.pc)[o] = f2bf(P);
        }
      }
      __builtin_amdgcn_fence(__ATOMIC_RELEASE, "wavefront");
      __builtin_amdgcn_wave_barrier();
    }
    if (prompt) {
      p.chA[((size_t)b * 64 + chunk) * 1024 + ch] = P;
      p.chU[((size_t)b * 64 + chunk) * 1024 + ch] = h;
    }
  }
}

#define VS 200
template <int NT>
__device__ __forceinline__ void attn_qtile(const bf16_t* sK, const bf16_t* sVt, const bf16_t* qptr, const int i_idx,
                                           const int jmin, const float sink, f32x4 (&o)[4], const int lane) {
  const int r15 = lane & 15, q4 = lane >> 4;
  bf16x8 qf[2];
  qf[0] = *(const bf16x8*)(qptr);
  qf[1] = *(const bf16x8*)(qptr + 32);
  const bf16_t* kb0 = sK + r15 * 64 + ((q4 ^ (r15 & 7)) * 8);
  const bf16_t* kb1 = sK + r15 * 64 + (((4 + q4) ^ (r15 & 7)) * 8);
  f32x4 s[NT];
#pragma unroll
  for (int t = 0; t < NT; t++) {
    s[t] = f32x4{0.f, 0.f, 0.f, 0.f};
    bf16x8 a0 = *(const bf16x8*)(kb0 + t * 1024);
    bf16x8 a1 = *(const bf16x8*)(kb1 + t * 1024);
    s[t] = __builtin_amdgcn_mfma_f32_16x16x32_bf16(a0, qf[0], s[t], 0, 0, 0);
    s[t] = __builtin_amdgcn_mfma_f32_16x16x32_bf16(a1, qf[1], s[t], 0, 0, 0);
    if (t & 1) __builtin_amdgcn_sched_barrier(0);
  }
  float m = sink;
  const int jb = q4 * 4 - i_idx;
#pragma unroll
  for (int t = 0; t < NT; t++)
#pragma unroll
    for (int j = 0; j < 4; j++) {
      const int dj = t * 16 + j + jb;
      const bool valid = (dj > 0) && (dj <= 128) && (dj + i_idx >= jmin);
      float v = valid ? s[t][j] * 0.125f : -1e30f;
      s[t][j] = v;
      m = fmaxf(m, v);
    }
  m = fmaxf(m, __shfl_xor(m, 16));
  m = fmaxf(m, __shfl_xor(m, 32));
  float sum = 0.f;
#pragma unroll
  for (int t = 0; t < NT; t++)
#pragma unroll
    for (int j = 0; j < 4; j++) {
      float e = __expf(s[t][j] - m);
      s[t][j] = e;
      sum += e;
    }
  sum += __shfl_xor(sum, 16);
  sum += __shfl_xor(sum, 32);
  sum += __expf(sink - m);
  const float inv = 1.0f / sum;
  const bf16_t* vbase = sVt + r15 * VS + q4 * 4;
#pragma unroll
  for (int kk = 0; kk < NT / 2; kk++) {
    union { bf16x8 v; unsigned u[4]; } pa;
    pa.u[0] = pack2bf(s[2 * kk][0] * inv, s[2 * kk][1] * inv);
    pa.u[1] = pack2bf(s[2 * kk][2] * inv, s[2 * kk][3] * inv);
    pa.u[2] = pack2bf(s[2 * kk + 1][0] * inv, s[2 * kk + 1][1] * inv);
    pa.u[3] = pack2bf(s[2 * kk + 1][2] * inv, s[2 * kk + 1][3] * inv);
#pragma unroll
    for (int dt = 0; dt < 4; dt++) {
      union { bf16x8 v; uint2 h[2]; } bv;
      bv.h[0] = *(const uint2*)(vbase + dt * 16 * VS + kk * 32);
      bv.h[1] = *(const uint2*)(vbase + dt * 16 * VS + kk * 32 + 16);
      o[dt] = __builtin_amdgcn_mfma_f32_16x16x32_bf16(pa.v, bv.v, o[dt], 0, 0, 0);
    }
    __builtin_amdgcn_sched_barrier(0);
  }
}

__device__ __forceinline__ void kv_to_lds(bf16_t* sK, bf16_t* sVt, int key, int dc, const uint4& kv, const uint4& vv) {
  *(uint4*)(sK + key * 64 + ((dc ^ (key & 7)) * 8)) = kv;
  bf16_t* vp = sVt + (dc * 8) * VS + key;
  vp[0 * VS] = (bf16_t)(vv.x & 0xFFFF); vp[1 * VS] = (bf16_t)(vv.x >> 16);
  vp[2 * VS] = (bf16_t)(vv.y & 0xFFFF); vp[3 * VS] = (bf16_t)(vv.y >> 16);
  vp[4 * VS] = (bf16_t)(vv.z & 0xFFFF); vp[5 * VS] = (bf16_t)(vv.z >> 16);
  vp[6 * VS] = (bf16_t)(vv.w & 0xFFFF); vp[7 * VS] = (bf16_t)(vv.w >> 16);
}

__device__ void phase_attn(const Params& p, char* smem, int bid, int nb) {
  const int tid = opaque_tid(), lane = tid & 63, wave = tid >> 6;
  bf16_t* sK = (bf16_t*)smem;
  bf16_t* sVt = sK + 192 * 64;
  for (int unit = bid; unit < 512 + 512; unit += nb) {
    __syncthreads();
    if (unit < 512) {
      const int kvh = unit & 3, n = (unit >> 2) & 63, b = unit >> 8;
      if (tid < 192) {
#pragma unroll 2
        for (int i = 0; i < 8; i++) {
          const int key = tid, dc = i;
          const int tk = n * 64 - 128 + key;
          uint4 kv = uint4{0, 0, 0, 0}, vv = uint4{0, 0, 0, 0};
          if (tk >= 0) {
            kv = *(const uint4*)(p.kb + (size_t)(b * 4096 + tk) * 256 + kvh * 64 + dc * 8);
            vv = *(const uint4*)(p.vb + (size_t)(b * 4096 + tk) * 256 + kvh * 64 + dc * 8);
          }
          kv_to_lds(sK, sVt, key, dc, kv, vv);
        }
      }
      __syncthreads();
      const int hq = kvh * 4 + wave;
      const float sink = p.sinks[hq];
      const int jmin = 128 - n * 64;
#pragma unroll 1
      for (int qt = 0; qt < 4; qt++) {
        const int i_idx = qt * 16 + (lane & 15);
        const int tokq = b * 4096 + n * 64 + i_idx;
        f32x4 o[4];
#pragma unroll
        for (int dt = 0; dt < 4; dt++) o[dt] = f32x4{0.f, 0.f, 0.f, 0.f};
        attn_qtile<12>(sK, sVt, p.qb + (size_t)tokq * 1024 + hq * 64 + (lane >> 4) * 8, i_idx, jmin, sink, o, lane);
        const int tokbase = b * 4096 + n * 64 + qt * 16;
        bf16_t* op = p.act + (size_t)(tokbase + (lane >> 4) * 4) * DM + hq * 64 + (lane & 15);
#pragma unroll
        for (int j = 0; j < 4; j++) {
          float sq = 0.f;
#pragma unroll
          for (int dt = 0; dt < 4; dt++) { op[(size_t)j * DM + dt * 16] = f2bf(o[dt][j]); sq += o[dt][j] * o[dt][j]; }
          sq = row16_sum(sq);
          if ((lane & 15) == 0) atomicAdd(&p.ssq[tokbase + (lane >> 4) * 4 + j], sq);
        }
      }
    } else {
      const int us = unit - 512;
      const int kvh = us & 3, b = us >> 2;
#pragma unroll 1
      for (int i = 0; i < 5; i++) {
        const int id = tid + i * 256;
        const int key = id % 160, dc = id / 160;
        uint4 kv = uint4{0, 0, 0, 0}, vv = uint4{0, 0, 0, 0};
        if (key < 128) {
          const float* ck = p.cache_k + (((size_t)b * 128 + key) * 4 + kvh) * 64 + dc * 8;
          const float* cv = p.cache_v + (((size_t)b * 128 + key) * 4 + kvh) * 64 + dc * 8;
          float4 a0 = *(const float4*)ck, a1 = *(const float4*)(ck + 4);
          float4 b0 = *(const float4*)cv, b1 = *(const float4*)(cv + 4);
          kv.x = pack2bf(a0.x, a0.y); kv.y = pack2bf(a0.z, a0.w); kv.z = pack2bf(a1.x, a1.y); kv.w = pack2bf(a1.z, a1.w);
          vv.x = pack2bf(b0.x, b0.y); vv.y = pack2bf(b0.z, b0.w); vv.z = pack2bf(b1.x, b1.y); vv.w = pack2bf(b1.z, b1.w);
        } else if (key < 136) {
          kv = *(const uint4*)(p.kb + (size_t)(NPROMPT + b * 8 + key - 128) * 256 + kvh * 64 + dc * 8);
          vv = *(const uint4*)(p.vb + (size_t)(NPROMPT + b * 8 + key - 128) * 256 + kvh * 64 + dc * 8);
        }
        kv_to_lds(sK, sVt, key, dc, kv, vv);
      }
      __syncthreads();
      if (wave < 2) {
        const int r = lane & 15;
        const int hq = kvh * 4 + wave * 2 + (r >> 3);
        const int s_idx = r & 7;
        const int tokq = NPROMPT + b * 8 + s_idx;
        f32x4 o[4];
#pragma unroll
        for (int dt = 0; dt < 4; dt++) o[dt] = f32x4{0.f, 0.f, 0.f, 0.f};
        attn_qtile<10>(sK, sVt, p.qb + (size_t)tokq * 1024 + hq * 64 + (lane >> 4) * 8, s_idx, 0, p.sinks[hq], o, lane);
#pragma unroll
        for (int j = 0; j < 4; j++) {
          const int rr = (lane >> 4) * 4 + j;
          const int hq2 = kvh * 4 + wave * 2 + (rr >> 3);
          bf16_t* op = p.act + (size_t)(NPROMPT + b * 8 + (rr & 7)) * DM + hq2 * 64 + (lane & 15);
          float sq = 0.f;
#pragma unroll
          for (int dt = 0; dt < 4; dt++) { op[dt * 16] = f2bf(o[dt][j]); sq += o[dt][j] * o[dt][j]; }
          sq = row16_sum(sq);
          if ((lane & 15) == 0) atomicAdd(&p.ssq[NPROMPT + b * 8 + (rr & 7)], sq);
        }
      }
    }
  }
}

__device__ void phase_lru_apply(const Params& p, int bid, int nb) {
  const int tid = opaque_tid(), lane = tid & 63, wave = tid >> 6;
  for (int u = bid * 4 + wave; u < 4096; u += nb * 4) {
    const bool prompt = u < 2048;
    const int n = u & 15;
    const int ch = n * 64 + lane;
    int b, chunk, tok0, T;
    if (prompt) { b = u >> 10; chunk = (u >> 4) & 63; tok0 = b * 4096 + chunk * 64; T = 64; }
    else { b = (u - 2048) >> 4; chunk = 0; tok0 = NPROMPT + b * 8; T = 8; }
    float hin = 0.f;
    if (prompt) {
#pragma unroll 1
      for (int k0 = 0; k0 < chunk; k0 += 16) {
        float av[16], uv[16];
#pragma unroll
        for (int k = 0; k < 16; k++) {
          const bool ok = (k0 + k) < chunk;
          const size_t o = ((size_t)b * 64 + (ok ? k0 + k : 0)) * 1024 + ch;
          av[k] = p.chA[o]; uv[k] = p.chU[o];
          if (!ok) { av[k] = 1.f; uv[k] = 0.f; }
        }
#pragma unroll
        for (int k = 0; k < 16; k++) hin = av[k] * hin + uv[k];
      }
    }
    float h = 0.f;
#pragma unroll 8
    for (int t = 0; t < T; t++) {
      const size_t tok = tok0 + t;
      h = bf2f_(((const bf16_t*)p.hloc)[tok * 1024 + ch]) + bf2f_(((const bf16_t*)p.pc)[tok * 1024 + ch]) * hin;
      float yg = bf2f_(p.zb[tok * INW + 2560 + ch]);
      const float yv = h * gelu_tanh(yg);
      p.act[tok * DM + 1024 + ch] = f2bf(yv);
      const float sq = wave_sum(yv * yv);
      if (lane == 0) atomicAdd(&p.ssq[NTOK + tok], sq);
    }
    if (prompt) {
      if (chunk == 63) {
        p.out[OFF_HP + (size_t)b * 1024 + ch] = h;
#pragma unroll
        for (int j = 0; j < 3; j++)
          p.out[OFF_CP + ((size_t)b * 3 + j) * 1024 + ch] = bf2f_(p.zb[(size_t)(b * 4096 + 4093 + j) * INW + 1536 + ch]);
      }
    } else {
      p.out[OFF_HS + (size_t)b * 1024 + ch] = h;
#pragma unroll
      for (int j = 0; j < 3; j++)
        p.out[OFF_CS + ((size_t)b * 3 + j) * 1024 + ch] = bf2f_(p.zb[(size_t)(NPROMPT + b * 8 + 5 + j) * INW + 1536 + ch]);
    }
  }
}

__device__ __forceinline__ int ordf(float f) { int b = __float_as_int(f); return b ^ ((b >> 31) & 0x7FFFFFFF); }
__device__ __forceinline__ float unordf(int o) { return __int_as_float(o ^ ((o >> 31) & 0x7FFFFFFF)); }
template <int CTRL>
__device__ __forceinline__ int dppi(int v) { return __builtin_amdgcn_update_dpp(v, v, CTRL, 0xF, 0xF, false); }
__device__ __forceinline__ int row16_allmax(int m) {
  m = max(m, dppi<0xB1>(m));
  m = max(m, dppi<0x4E>(m));
  m = max(m, dppi<0x141>(m));
  m = max(m, dppi<0x140>(m));
  return m;
}
__device__ __forceinline__ int quad_allmax(int m) {
  m = max(m, dppi<0xB1>(m));
  m = max(m, dppi<0x4E>(m));
  return m;
}

__device__ void phase_peer_select(const Params& p, char* smem, int bid, int nb) {
  const int tid = opaque_tid(), lane = tid & 63, wave = tid >> 6;
  int* tab = (int*)smem;
  int* st = tab + 64 + wave * 512;
  if (tid < 64) {
    int e = -1, cnt = 0;
    for (int i = 0; i < 16; i++) {
      int nn = 16 / (i + 1);
      if (tid >= cnt && tid < cnt + nn) e = i | ((tid - cnt) << 4);
      cnt += nn;
    }
    tab[tid] = e;
  }
  __syncthreads();
  const int r15 = lane & 15, q4 = lane >> 4;
  for (int unit = bid * 4 + wave; unit < 576 * 8; unit += nb * 4) {
    const int tt = unit >> 3, hh = unit & 7;
#pragma unroll 1
    for (int c = 0; c < 2; c++) {
      f32x4 acc[8];
#pragma unroll
      for (int kt = 0; kt < 8; kt++) acc[kt] = f32x4{0.f, 0.f, 0.f, 0.f};
      const bf16_t* arow = p.pq + (size_t)(tt * 16 + r15) * DM + hh * 256 + c * 128 + q4 * 8;
      const bf16_t* brow = p.sk_bf + ((size_t)((hh * 2 + c) * 128 + r15)) * 128 + q4 * 8;
      bf16x8 af4[4];
#pragma unroll
      for (int ks = 0; ks < 4; ks++) af4[ks] = *(const bf16x8*)(arow + ks * 32);
      bf16x8 bq0[8], bq1[8];
#pragma unroll
      for (int kt = 0; kt < 8; kt++) bq0[kt] = *(const bf16x8*)(brow + kt * 16 * 128);
#pragma unroll
      for (int kt = 0; kt < 8; kt++) bq1[kt] = *(const bf16x8*)(brow + kt * 16 * 128 + 32);
      __builtin_amdgcn_sched_barrier(0);
#pragma unroll
      for (int kt = 0; kt < 8; kt++) acc[kt] = __builtin_amdgcn_mfma_f32_16x16x32_bf16(af4[0], bq0[kt], acc[kt], 0, 0, 0);
#pragma unroll
      for (int kt = 0; kt < 8; kt++) bq0[kt] = *(const bf16x8*)(brow + kt * 16 * 128 + 64);
      __builtin_amdgcn_sched_barrier(0);
#pragma unroll
      for (int kt = 0; kt < 8; kt++) acc[kt] = __builtin_amdgcn_mfma_f32_16x16x32_bf16(af4[1], bq1[kt], acc[kt], 0, 0, 0);
#pragma unroll
      for (int kt = 0; kt < 8; kt++) bq1[kt] = *(const bf16x8*)(brow + kt * 16 * 128 + 96);
      __builtin_amdgcn_sched_barrier(0);
#pragma unroll
      for (int kt = 0; kt < 8; kt++) acc[kt] = __builtin_amdgcn_mfma_f32_16x16x32_bf16(af4[2], bq0[kt], acc[kt], 0, 0, 0);
#pragma unroll
      for (int kt = 0; kt < 8; kt++) acc[kt] = __builtin_amdgcn_mfma_f32_16x16x32_bf16(af4[3], bq1[kt], acc[kt], 0, 0, 0);
      int key[8][4];
#pragma unroll
      for (int kt = 0; kt < 8; kt++)
#pragma unroll
        for (int j = 0; j < 4; j++) key[kt][j] = (ordf(acc[kt][j]) & ~127) | (127 - (kt * 16 + r15));
#define CE_(a, b) { const int hi_ = max(key[a][j], key[b][j]); const int lo_ = min(key[a][j], key[b][j]); key[a][j] = hi_; key[b][j] = lo_; }
#pragma unroll
      for (int j = 0; j < 4; j++) {
        CE_(0, 1) CE_(2, 3) CE_(4, 5) CE_(6, 7)
        CE_(0, 2) CE_(1, 3) CE_(4, 6) CE_(5, 7)
        CE_(1, 2) CE_(5, 6)
        CE_(0, 4) CE_(1, 5) CE_(2, 6) CE_(3, 7)
        CE_(2, 4) CE_(3, 5)
        CE_(1, 2) CE_(3, 4) CE_(5, 6)
      }
#undef CE_
      int top[4] = {INT32_MIN, INT32_MIN, INT32_MIN, INT32_MIN};
#pragma unroll 1
      for (int it = 0; it < 16; it++) {
#pragma unroll
        for (int j = 0; j < 4; j++) {
          const int m = row16_allmax(key[0][j]);
          const bool own = (key[0][j] == m);
#pragma unroll
          for (int kt = 0; kt < 7; kt++) key[kt][j] = own ? key[kt + 1][j] : key[kt][j];
          key[7][j] = own ? INT32_MIN : key[7][j];
          top[j] = (r15 == it) ? m : top[j];
        }
      }
#pragma unroll
      for (int j = 0; j < 4; j++) st[c * 256 + (q4 * 4 + j) * 16 + r15] = top[j];
    }
    __builtin_amdgcn_fence(__ATOMIC_RELEASE, "wavefront");
    __builtin_amdgcn_wave_barrier();
    __builtin_amdgcn_fence(__ATOMIC_ACQUIRE, "wavefront");
    const int tl = lane >> 2, sub = lane & 3;
    int ck[13];
#pragma unroll
    for (int q = 0; q < 13; q++) {
      const int pidx = sub + 4 * q;
      const int e = tab[pidx];
      int kv = INT32_MIN;
      if (e >= 0) {
        int ka = st[tl * 16 + (e & 15)];
        int kb2 = st[256 + tl * 16 + (e >> 4)];
        float s = unordf(ka & ~127) + unordf(kb2 & ~127);
        kv = (ordf(s) & ~63) | pidx;
      }
      ck[q] = kv;
    }
    int mine[4] = {0, 0, 0, 0};
    int m0 = 0;
#pragma unroll
    for (int r = 0; r < 16; r++) {
      int m = ck[0];
#pragma unroll
      for (int q = 1; q < 13; q++) m = max(m, ck[q]);
      m = quad_allmax(m);
#pragma unroll
      for (int q = 0; q < 13; q++) ck[q] = (ck[q] == m) ? INT32_MIN : ck[q];
      if (r == 0) m0 = m;
      mine[r >> 2] = (sub == (r & 3)) ? m : mine[r >> 2];
    }
    const float mx = unordf(m0 & ~63);
    float ev[4];
    float sum = 0.f;
#pragma unroll
    for (int k = 0; k < 4; k++) { ev[k] = __expf(unordf(mine[k] & ~63) - mx); sum += ev[k]; }
    sum += __shfl_xor(sum, 1);
    sum += __shfl_xor(sum, 2);
    const float inv = 1.0f / sum;
#pragma unroll
    for (int k = 0; k < 4; k++) {
      const int e = tab[mine[k] & 63];
      const int ia = 127 - (st[tl * 16 + (e & 15)] & 127);
      const int ib = 127 - (st[256 + tl * 16 + (e >> 4)] & 127);
      const size_t o = (size_t)(tt * 16 + tl) * 128 + hh * 16 + k * 4 + sub;
      p.sel_eid[o] = ia * 128 + ib;
      p.sel_g[o] = ev[k] * inv;
    }
    __builtin_amdgcn_fence(__ATOMIC_RELEASE, "wavefront");
    __builtin_amdgcn_wave_barrier();
  }
}

struct XInfo { int wx, nwx, popidx, npop; };
__device__ __forceinline__ float dppf_add8(float v) {
  v += __int_as_float(__builtin_amdgcn_update_dpp(0, __float_as_int(v), 0xB1, 0xF, 0xF, false));
  v += __int_as_float(__builtin_amdgcn_update_dpp(0, __float_as_int(v), 0x4E, 0xF, 0xF, false));
  v += __int_as_float(__builtin_amdgcn_update_dpp(0, __float_as_int(v), 0x141, 0xF, 0xF, false));
  return v;
}
__device__ __forceinline__ float dot16_fp8v(const u32x4& r, const f32x2* h2) {
  f32x2 acc = f32x2{0.f, 0.f};
#pragma unroll
  for (int q = 0; q < 4; q++) {
    f32x2 lo = __builtin_amdgcn_cvt_pk_f32_fp8((int)r[q], false);
    f32x2 hi = __builtin_amdgcn_cvt_pk_f32_fp8((int)r[q], true);
    acc = lo * h2[q * 2] + acc;
    acc = hi * h2[q * 2 + 1] + acc;
  }
  return acc[0] + acc[1];
}
__device__ __forceinline__ void axpy16_fp8v(float w, const u32x4& r, f32x2* f2) {
  const f32x2 w2 = f32x2{w, w};
#pragma unroll
  for (int q = 0; q < 4; q++) {
    f32x2 lo = __builtin_amdgcn_cvt_pk_f32_fp8((int)r[q], false);
    f32x2 hi = __builtin_amdgcn_cvt_pk_f32_fp8((int)r[q], true);
    f2[q * 2] = w2 * lo + f2[q * 2];
    f2[q * 2 + 1] = w2 * hi + f2[q * 2 + 1];
  }
}
#define NITEM (NTOK * 128)
__device__ __forceinline__ void phase_peer_u(const Params& p, const XInfo& xi) {
  const int tid = opaque_tid(), lane = tid & 63, j8 = lane & 7, g = lane >> 3;
  int nown = 0;
  for (int ss = 0; ss < 16; ss++) nown += (((ss >> 1) % xi.npop) == xi.popidx) ? 1 : 0;
  const int nitems = nown * (NTOK / 8);
#pragma unroll 1
  for (int idx = xi.wx; idx < nitems; idx += xi.nwx) {
    const int ord = idx / (NTOK / 8), B = idx % (NTOK / 8);
    int ss = 0;
    { int c = 0; for (int q = 0; q < 16; q++) if (((q >> 1) % xi.npop) == xi.popidx) { if (c == ord) ss = q; c++; } }
    const unsigned char* ub = p.u8 + ss * 128 + j8 * 16;
    bf16_t* pdst = (bf16_t*)p.pd + (size_t)ss * NITEM;
    {
      const int tok = B * 8 + g;
      const bool valid = true;
      f32x2 h2[8];
      {
        const bf16_t* hrow = p.act2 + (size_t)tok * DM + ss * 128 + j8 * 16;
        u32x4 r0 = *(const u32x4*)(hrow), r1 = *(const u32x4*)(hrow + 8);
#pragma unroll
        for (int q = 0; q < 4; q++) {
          h2[q] = f32x2{bflo(r0[q]), bfhi(r0[q])};
          h2[4 + q] = f32x2{bflo(r1[q]), bfhi(r1[q])};
        }
      }
      const int* ep = p.sel_eid + (size_t)tok * 128;
      i32x8 e;
#pragma unroll
      for (int k = 0; k < 8; k++) e[k] = ep[k];
#pragma unroll 1
      for (int it0 = 0; it0 < 128; it0 += 8) {
        u32x4 r[8];
#pragma unroll
        for (int k = 0; k < 8; k++) r[k] = *(const u32x4*)(ub + (size_t)e[k] * DM);
        const int itn = (it0 + 8) & 127;
#pragma unroll
        for (int k = 0; k < 8; k++) e[k] = ep[itn + k];
        float d[8];
#pragma unroll
        for (int k = 0; k < 8; k++) d[k] = dppf_add8(dot16_fp8v(r[k], h2));
        float o = d[0];
#pragma unroll
        for (int k = 1; k < 8; k++) o = (j8 == k) ? d[k] : o;
        if (valid) pdst[(size_t)tok * 128 + it0 + j8] = f2bf(o);
      }
    }
  }
}
__device__ void phase_peer_w(const Params& p, int bid, int nb) {
  const int tid = opaque_tid();
  for (int i = bid * 256 + tid; i < NITEM; i += nb * 256) {
    float sacc = 0.f;
#pragma unroll
    for (int ss = 0; ss < 16; ss++) sacc += bf2f_(((const bf16_t*)p.pd)[(size_t)ss * NITEM + i]);
    const float rf = rsqrtf(p.ssq[2 * NTOK + (i >> 7)] * (1.0f / 2048.0f) + EPSV);
    p.sel_g[i] = gelu_tanh(sacc * rf * (1.0f / 256.0f)) * p.sel_g[i] * (1.0f / 16.0f);
  }
}
__device__ __forceinline__ void phase_peer_v(const Params& p, const XInfo& xi) {
  const int tid = opaque_tid(), lane = tid & 63, j8 = lane & 7, g = lane >> 3;
  int nown = 0;
  for (int ss = 0; ss < 16; ss++) nown += (((ss >> 1) % xi.npop) == xi.popidx) ? 1 : 0;
  const int nitems = nown * (NTOK / 8);
#pragma unroll 1
  for (int idx = xi.wx; idx < nitems; idx += xi.nwx) {
    const int ord = idx / (NTOK / 8), B = idx % (NTOK / 8);
    int ss = 0;
    { int c = 0; for (int q = 0; q < 16; q++) if (((q >> 1) % xi.npop) == xi.popidx) { if (c == ord) ss = q; c++; } }
    const unsigned char* vb8 = p.v8 + ss * 128 + j8 * 16;
    {
      const int tok = B * 8 + g;
      const bool valid = true;
      f32x2 f2[8];
#pragma unroll
      for (int q = 0; q < 8; q++) f2[q] = f32x2{0.f, 0.f};
      const int* ep = p.sel_eid + (size_t)tok * 128;
      const float* wp = p.sel_g + (size_t)tok * 128;
      i32x8 e; f32x8 w;
#pragma unroll
      for (int k = 0; k < 8; k++) { e[k] = ep[k]; w[k] = wp[k]; }
#pragma unroll 1
      for (int it0 = 0; it0 < 128; it0 += 8) {
        u32x4 r[8]; float wc[8];
#pragma unroll
        for (int k = 0; k < 8; k++) { r[k] = *(const u32x4*)(vb8 + (size_t)e[k] * DM); wc[k] = w[k]; }
        const int itn = (it0 + 8) & 127;
#pragma unroll
        for (int k = 0; k < 8; k++) { e[k] = ep[itn + k]; w[k] = wp[itn + k]; }
#pragma unroll
        for (int k = 0; k < 8; k++) axpy16_fp8v(wc[k], r[k], f2);
      }
      if (valid) {
        float* orow = p.out + OFF_Y + (size_t)tok * DM + ss * 128 + j8 * 16;
#pragma unroll
        for (int q = 0; q < 4; q++) {
          float4 a = *(float4*)(orow + q * 4);
          a.x += f2[q * 2][0]; a.y += f2[q * 2][1]; a.z += f2[q * 2 + 1][0]; a.w += f2[q * 2 + 1][1];
          *(float4*)(orow + q * 4) = a;
        }
      }
    }
  }
}

#define XB_TMO      128
#define XB_XCNT(j)  (256  + 64 * (j))
#define XB_XSUB(j)  (1280 + 64 * (j))
#define XB_XGEN(j)  (2304 + 64 * (j))
#define XB_TOP      3328
#define XB_TOPGEN   3392
#define XCD_BAR_WORDS 3456
#define XB_SPIN_CAP (1u << 22)
#define LAS __attribute__((address_space(3)))
__device__ __forceinline__ unsigned xb_ld(unsigned* p)              { return __hip_atomic_load(p, __ATOMIC_RELAXED, __HIP_MEMORY_SCOPE_AGENT); }
__device__ __forceinline__ unsigned xb_add(unsigned* p, unsigned v) { return __hip_atomic_fetch_add(p, v, __ATOMIC_RELAXED, __HIP_MEMORY_SCOPE_AGENT); }
__device__ __forceinline__ unsigned xb_xcc_id() { return (unsigned)__builtin_amdgcn_s_getreg((3 << 11) | 20) & 0xFu; }
#define XB_SPIN(cond, bar) do { unsigned _sp = 0; while (cond) { __builtin_amdgcn_s_sleep(24); \
    if ((++_sp & 255u) == 0u) { if (xb_ld(&(bar)[XB_TMO])) break; if (_sp > XB_SPIN_CAP) { atomicAdd(&(bar)[XB_TMO], 1u); break; } } } } while (0)
struct XcdBarrier { unsigned* bar; unsigned x; unsigned nloc, nx; };
__device__ __forceinline__ XcdBarrier xcd_barrier_post(unsigned* bar) {
  XcdBarrier b; b.bar = bar; b.x = xb_xcc_id(); b.nloc = 0u; b.nx = 0u;
  if (threadIdx.x == 0) (void)xb_add(&bar[XB_XCNT(b.x)], 1u);
  return b;
}
__device__ __forceinline__ void xcd_barrier_complete(unsigned* bar, unsigned x, unsigned& nloc, unsigned& nx) {
  const unsigned G = gridDim.x * gridDim.y * gridDim.z;
  unsigned sum, cnt, mine, sp = 0u;
  for (;;) {
    sum = 0u; cnt = 0u; mine = 0u;
#pragma unroll
    for (unsigned j = 0; j < 16; ++j) { const unsigned c = xb_ld(&bar[XB_XCNT(j)]); sum += c; cnt += (c > 0u) ? 1u : 0u; mine = (j == x) ? c : mine; }
    if (sum == G) break;
    __builtin_amdgcn_s_sleep(1);
    if ((++sp & 255u) == 0u) { if (xb_ld(&bar[XB_TMO])) break; if (sp > XB_SPIN_CAP) { atomicAdd(&bar[XB_TMO], 1u); break; } }
  }
  nloc = mine > 0u ? mine : 1u; nx = cnt > 0u ? cnt : 1u;
}
__device__ __forceinline__ void xcd_barrier(XcdBarrier& b) {
  asm volatile("s_waitcnt vmcnt(0)" ::: "memory");
  __syncthreads();
  if (threadIdx.x == 0) {
    unsigned* bar = b.bar;
    __builtin_amdgcn_s_waitcnt(0);
    unsigned nloc = b.nloc, nx = b.nx;
    if (nloc == 0u) { xcd_barrier_complete(bar, b.x, nloc, nx); b.nloc = nloc; b.nx = nx; }
    const unsigned old = xb_add(&bar[XB_XSUB(b.x)], 1u);
    const unsigned gen = old / nloc;
    if (old + 1u == (gen + 1u) * nloc) {
      __builtin_amdgcn_fence(__ATOMIC_RELEASE, "agent");
      asm volatile("s_waitcnt vmcnt(0)" ::: "memory");
      const unsigned og = xb_add(&bar[XB_TOP], 1u);
      const unsigned tg = og / nx;
      if (og + 1u == (tg + 1u) * nx) xb_add(&bar[XB_TOPGEN], 1u);
      else XB_SPIN(xb_ld(&bar[XB_TOPGEN]) == tg, bar);
      __builtin_amdgcn_fence(__ATOMIC_ACQUIRE, "agent");
      xb_add(&bar[XB_XGEN(b.x)], 1u);
      asm volatile("s_waitcnt vmcnt(0)" ::: "memory");
    } else {
      XB_SPIN(xb_ld(&bar[XB_XGEN(b.x)]) == gen, bar);
      __builtin_amdgcn_fence(__ATOMIC_ACQUIRE, "agent");
      asm volatile("s_waitcnt vmcnt(0)" ::: "memory");
    }
  }
  __syncthreads();
}

#define NPHASE 10
__device__ __forceinline__ void run_phase(const Params& p, char* smem, int ph, int bid, int nb, const XInfo& xi, const int role) {
  switch (ph) {
    case 0: phase_convert(p, smem, bid, nb); break;
    case 1: gemm_phase<0, 4>(p, smem, bid, nb, p.act, p.w_in_t, INW); break;
    case 2: phase_qkprep(p, bid, nb); phase_lru_local(p, smem, bid, nb); break;
    case 3: phase_attn(p, smem, bid, nb); phase_lru_apply(p, bid, nb); break;
    case 4: gemm_phase<1, 3>(p, smem, bid, nb, p.act, p.w_out_t, DM); break;
    case 5: gemm_phase<2, 3>(p, smem, bid, nb, p.act2, p.w_pq_t, DM); break;
    case 6:
      if (role == 0) {
        convert_table_fp8(p.peer_u, p.u8, 256.0f, bid, nb, p.g_ffn);
        convert_table_fp8(p.peer_v, p.v8, 16.0f, bid, nb, nullptr);
        copy_cache_rows(p, bid, nb);
        phase_peer_select(p, smem, bid, nb);
      } else {
        phase_peer_select(p, smem, bid, nb);
        convert_table_fp8(p.peer_u, p.u8, 256.0f, bid, nb, p.g_ffn);
        convert_table_fp8(p.peer_v, p.v8, 16.0f, bid, nb, nullptr);
        copy_cache_rows(p, bid, nb);
      }
      break;
    case 7: phase_peer_u(p, xi); break;
    case 8: phase_peer_w(p, bid, nb); break;
    case 9: phase_peer_v(p, xi); break;
  }
}

#if ONE_LAUNCH
__global__ void __launch_bounds__(256, 2) k_mega(Params p) {
  __shared__ __attribute__((aligned(16))) char smem[65536];
  __shared__ int s_rank[4];
  XcdBarrier xb; xb.bar = p.bar; xb.x = xb_xcc_id(); xb.nloc = 0u; xb.nx = 0u;
  if (threadIdx.x == 0) {
    s_rank[0] = (int)xb_add(&p.bar[XB_XCNT(xb.x)], 1u);
    const unsigned hwid = (unsigned)__builtin_amdgcn_s_getreg((31 << 11) | 4);
    const unsigned slot = (hwid >> 8) & 0xFFu;
    s_rank[1] = (int)(xb_add(&p.bar[XCD_BAR_WORDS + xb.x * 256 + slot], 1u) & 1u);
  }
  __syncthreads();
  const int rank = s_rank[0];
  const int role = (blockIdx.x >= gridDim.x / 2) ? 1 : 0;
  XInfo xi{0, 0, 0, 1};
#pragma unroll 1
  for (int ph = 0; ph < NPHASE; ph++) {
    if (ph == 7) {
      int npop = 0, popidx = 0, nloc = 1;
      for (int j = 0; j < 16; j++) {
        const int c = (int)xb_ld(&p.bar[XB_XCNT(j)]);
        if (c > 0) { if (j == (int)xb.x) { popidx = npop; nloc = c; } npop++; }
      }
      xi.wx = rank * 4 + (threadIdx.x >> 6); xi.nwx = nloc * 4; xi.popidx = popidx; xi.npop = npop;
    }
    run_phase(p, smem, ph, blockIdx.x, gridDim.x, xi, role);
    if (ph + 1 < NPHASE) xcd_barrier(xb);
  }
}
#endif

extern "C" void kernel_launch(void* const* d_in, const int* in_sizes, int n_in, void* d_out, int out_size, void* d_ws,
                              size_t ws_size, hipStream_t stream) {
  Params p{};
  const float* const* in = (const float* const*)d_in;
  p.x_prompt = in[0]; p.x_sample = in[1]; p.cache_k = in[2]; p.cache_v = in[3]; p.state_conv = in[4]; p.state_h = in[5];
  p.g_mix = in[6]; p.w_in = in[7]; p.g_q = in[8]; p.g_k = in[9]; p.sinks = in[10]; p.conv_w = in[11]; p.conv_b = in[12];
  p.w_a = in[13]; p.b_a = in[14]; p.w_x = in[15]; p.b_x = in[16]; p.lam = in[17]; p.g_ao = in[18]; p.g_lo = in[19];
  p.w_out = in[20]; p.g_ffn = in[21]; p.w_pq = in[22]; p.sub_keys = in[23]; p.peer_u = in[24]; p.peer_v = in[25];
  p.out = (float*)d_out;
  char* w = (char*)d_ws;
  size_t off = 0;
  auto take = [&](size_t bytes) { char* r = w + off; off += (bytes + 255) & ~(size_t)255; return r; };
  p.w_in_t = (bf16_t*)take((size_t)INW * DM * 2);
  p.w_out_t = (bf16_t*)take((size_t)DM * DM * 2);
  p.w_pq_t = (bf16_t*)take((size_t)DM * DM * 2);
  p.sk_bf = (bf16_t*)take((size_t)262144 * 2);
  p.wg_t = (bf16_t*)take((size_t)131072 * 2);
  p.u8 = (unsigned char*)take((size_t)16384 * DM);
  p.v8 = (unsigned char*)take((size_t)16384 * DM);
  p.act = (bf16_t*)take((size_t)NTOK * DM * 2);
  p.z = (float*)take((size_t)NTOK * INW * 4);
  p.zb = (bf16_t*)p.z;
  p.qb = (bf16_t*)take((size_t)NTOK * 1024 * 2);
  p.kb = (bf16_t*)take((size_t)NTOK * 256 * 2);
  p.vb = (bf16_t*)take((size_t)NTOK * 256 * 2);
  p.hloc = (float*)take((size_t)NTOK * 1024 * 4);
  p.pc = (float*)take((size_t)NTOK * 1024 * 4);
  p.chA = (float*)take((size_t)2 * 64 * 1024 * 4);
  p.chU = (float*)take((size_t)2 * 64 * 1024 * 4);
  p.mixraw = (float*)take((size_t)NTOK * DM * 4);
  p.act2 = (bf16_t*)p.mixraw;
  p.ssq = (float*)take((size_t)3 * NTOK * 4);
  p.bar = (unsigned*)take((size_t)(XCD_BAR_WORDS + 16 * 256) * 4);
  p.pd = p.hloc;
  p.pq = (bf16_t*)p.z;
  p.sel_eid = (int*)((char*)p.z + (size_t)NTOK * DM * 2);
  p.sel_g = (float*)((char*)p.z + (size_t)NTOK * DM * 2 + (size_t)NTOK * 128 * 4);
  if (off > ws_size) { fprintf(stderr, "workspace too small: need %zu have %zu\n", off, ws_size); return; }

  static int grid_blocks = 0;
  if (!grid_blocks) {
    int dev = 0, cus = 0, per_cu = 0;
    (void)hipGetDevice(&dev);
    (void)hipDeviceGetAttribute(&cus, hipDeviceAttributeMultiprocessorCount, dev);
#if ONE_LAUNCH
    (void)hipOccupancyMaxActiveBlocksPerMultiprocessor(&per_cu, k_mega, 256, 0);
#endif
    if (per_cu > 2) per_cu = 2;
    if (per_cu < 1) per_cu = 1;
    grid_blocks = cus * per_cu;
  }
#if ONE_LAUNCH
  (void)hipMemsetAsync(p.bar, 0, (size_t)(XCD_BAR_WORDS + 16 * 256) * 4, stream);
  void* args[] = {&p};
  hipError_t e = hipLaunchCooperativeKernel((void*)k_mega, dim3(grid_blocks), dim3(256), args, 0, stream);
  if (e != hipSuccess) fprintf(stderr, "cooperative launch failed: %s (grid %d)\n", hipGetErrorString(e), grid_blocks);
#endif
}
```

```cpp
#include <hip/hip_runtime.h>
#include <hip/hip_cooperative_groups.h>
#include <cstdio>
#include <cstdint>
namespace cg = cooperative_groups;

#ifndef ONE_LAUNCH
#define ONE_LAUNCH 1
#endif

typedef unsigned short bf16_t;
using bf16x8 = __attribute__((ext_vector_type(8))) short;
using f32x4 = __attribute__((ext_vector_type(4))) float;
using f32x2 = __attribute__((ext_vector_type(2))) float;
using u32x4 = __attribute__((ext_vector_type(4))) unsigned;
using i32x8 = __attribute__((ext_vector_type(8))) int;
using f32x8 = __attribute__((ext_vector_type(8))) float;

#define NTOK 9216
#define NPROMPT 8192
#define DM 2048
#define INW 3584
#define EPSV 1e-6f

struct Params {
  const float *x_prompt, *x_sample, *cache_k, *cache_v, *state_conv, *state_h;
  const float *g_mix, *w_in, *g_q, *g_k, *sinks, *conv_w, *conv_b, *w_a, *b_a, *w_x, *b_x, *lam;
  const float *g_ao, *g_lo, *w_out, *g_ffn, *w_pq, *sub_keys, *peer_u, *peer_v;
  float* out;
  bf16_t *w_in_t, *w_out_t, *w_pq_t, *wg_t, *sk_bf, *act, *qb, *kb, *vb, *pq;
  float *z, *hloc, *pc, *chA, *chU, *mixraw, *sel_g;
  int* sel_eid;
  float* pd;
  bf16_t* zb;
  float* ssq;
  bf16_t* act2;
  unsigned char *u8, *v8;
  unsigned* bar;
};

#define OFF_Y 0
#define OFF_KP 18874368
#define OFF_VP 18939904
#define OFF_CP 19005440
#define OFF_HP 19011584
#define OFF_KS 19013632
#define OFF_VS 23207936
#define OFF_CS 27402240
#define OFF_HS 27795456

__device__ __forceinline__ int opaque_tid() { int t = threadIdx.x; asm volatile("" : "+v"(t)); return t; }
__device__ __forceinline__ bf16_t f2bf(float f) {
  unsigned u = __float_as_uint(f);
  u += 0x7FFFu + ((u >> 16) & 1u);
  return (bf16_t)(u >> 16);
}
__device__ __forceinline__ unsigned pack2bf(float a, float b) {
  return (unsigned)f2bf(a) | ((unsigned)f2bf(b) << 16);
}
__device__ __forceinline__ float bf2f_(bf16_t b) { return __uint_as_float((unsigned)b << 16); }
__device__ __forceinline__ float bflo(unsigned u) { return __uint_as_float(u << 16); }
__device__ __forceinline__ float bfhi(unsigned u) { return __uint_as_float(u & 0xFFFF0000u); }

__device__ __forceinline__ float wave_sum(float v) {
#pragma unroll
  for (int o = 32; o > 0; o >>= 1) v += __shfl_xor(v, o);
  return v;
}
__device__ __forceinline__ float row16_sum(float v) {
  v += __int_as_float(__builtin_amdgcn_update_dpp(0, __float_as_int(v), 0xB1, 0xF, 0xF, false));
  v += __int_as_float(__builtin_amdgcn_update_dpp(0, __float_as_int(v), 0x4E, 0xF, 0xF, false));
  v += __int_as_float(__builtin_amdgcn_update_dpp(0, __float_as_int(v), 0x141, 0xF, 0xF, false));
  v += __int_as_float(__builtin_amdgcn_update_dpp(0, __float_as_int(v), 0x140, 0xF, 0xF, false));
  return v;
}
__device__ __forceinline__ float gelu_tanh(float x) {
  float y = 0.7978845608028654f * (x + 0.044715f * x * x * x);
  float e = __expf(2.0f * y);
  float t = 1.0f - 2.0f / (e + 1.0f);
  return 0.5f * x * (1.0f + t);
}
__device__ __forceinline__ float sigmoidf_(float x) { return 1.0f / (1.0f + __expf(-x)); }

__device__ __forceinline__ const float* xrow(const Params& p, int tok) {
  return tok < NPROMPT ? p.x_prompt + (size_t)tok * DM : p.x_sample + (size_t)(tok - NPROMPT) * DM;
}

__device__ __forceinline__ void rms_row_to_bf16(const float* __restrict__ src, const float* __restrict__ g,
                                                bf16_t* __restrict__ dst, int lane) {
  float4 v[8];
  float ss = 0.f;
#pragma unroll
  for (int i = 0; i < 8; i++) {
    v[i] = *(const float4*)(src + i * 256 + lane * 4);
    ss += v[i].x * v[i].x + v[i].y * v[i].y + v[i].z * v[i].z + v[i].w * v[i].w;
  }
  ss = wave_sum(ss);
  float r = rsqrtf(ss * (1.0f / DM) + EPSV);
#pragma unroll
  for (int i = 0; i < 8; i++) {
    float4 gg = *(const float4*)(g + i * 256 + lane * 4);
    uint2 o;
    o.x = pack2bf(v[i].x * r * gg.x, v[i].y * r * gg.y);
    o.y = pack2bf(v[i].z * r * gg.z, v[i].w * r * gg.w);
    *(uint2*)(dst + i * 256 + lane * 4) = o;
  }
}

__device__ void convert_table_fp8(const float* __restrict__ src, unsigned char* __restrict__ dst, const float sc, int worker, int nworkers, const float* __restrict__ colg) {
  const int tid = opaque_tid();
  const size_t units = (size_t)16384 * 2048 / 16;
  const size_t stride = (size_t)nworkers * 256;
  for (size_t i = (size_t)worker * 256 + tid; i < units; i += 2 * stride) {
    const size_t j1 = (i + stride < units) ? i + stride : i;
    f32x4 a0[4], a1[4];
#pragma unroll
    for (int q = 0; q < 4; q++) a0[q] = __builtin_nontemporal_load((const f32x4*)(src + i * 16 + q * 4));
#pragma unroll
    for (int q = 0; q < 4; q++) a1[q] = __builtin_nontemporal_load((const f32x4*)(src + j1 * 16 + q * 4));
    if (colg) {
#pragma unroll
      for (int q = 0; q < 4; q++) {
        const f32x4 g0 = *(const f32x4*)(colg + ((i * 16 + q * 4) & 2047));
        const f32x4 g1 = *(const f32x4*)(colg + ((j1 * 16 + q * 4) & 2047));
        a0[q] *= g0; a1[q] *= g1;
      }
    }
    u32x4 o0, o1;
#pragma unroll
    for (int q = 0; q < 4; q++) {
      int w = 0;
      w = __builtin_amdgcn_cvt_pk_fp8_f32(fminf(fmaxf(a0[q][0] * sc, -448.f), 448.f), fminf(fmaxf(a0[q][1] * sc, -448.f), 448.f), w, false);
      w = __builtin_amdgcn_cvt_pk_fp8_f32(fminf(fmaxf(a0[q][2] * sc, -448.f), 448.f), fminf(fmaxf(a0[q][3] * sc, -448.f), 448.f), w, true);
      o0[q] = (unsigned)w;
      int w1 = 0;
      w1 = __builtin_amdgcn_cvt_pk_fp8_f32(fminf(fmaxf(a1[q][0] * sc, -448.f), 448.f), fminf(fmaxf(a1[q][1] * sc, -448.f), 448.f), w1, false);
      w1 = __builtin_amdgcn_cvt_pk_fp8_f32(fminf(fmaxf(a1[q][2] * sc, -448.f), 448.f), fminf(fmaxf(a1[q][3] * sc, -448.f), 448.f), w1, true);
      o1[q] = (unsigned)w1;
    }
    *(u32x4*)(dst + i * 16) = o0;
    *(u32x4*)(dst + j1 * 16) = o1;
  }
}

__device__ void copy_cache_rows(const Params& p, int bid, int nb) {
  const int tid = opaque_tid();
  {
    const int per_b = 120 * 256 / 4;
    const int half = 128 * per_b, quarter = half / 2;
    for (int i = bid * 256 + tid; i < quarter; i += nb * 256) {
      const int j0 = i, j1 = i + quarter;
      const int b0 = j0 / per_b, r0 = j0 % per_b, b1 = j1 / per_b, r1 = j1 % per_b;
      const size_t s0 = (size_t)b0 * 32768 + 8 * 256 + r0 * 4, s1 = (size_t)b1 * 32768 + 8 * 256 + r1 * 4;
      const size_t d0 = (size_t)b0 * 32768 + r0 * 4, d1 = (size_t)b1 * 32768 + r1 * 4;
      const f32x4 v0 = *(const f32x4*)(p.cache_k + s0);
      const f32x4 v1 = *(const f32x4*)(p.cache_k + s1);
      const f32x4 v2 = *(const f32x4*)(p.cache_v + s0);
      const f32x4 v3 = *(const f32x4*)(p.cache_v + s1);
      *(f32x4*)(p.out + OFF_KS + d0) = v0;
      *(f32x4*)(p.out + OFF_KS + d1) = v1;
      *(f32x4*)(p.out + OFF_VS + d0) = v2;
      *(f32x4*)(p.out + OFF_VS + d1) = v3;
    }
  }
}

__device__ void phase_convert(const Params& p, char* smem, int bid, int nb) {
  const int tid = opaque_tid(), lane = tid & 63, wave = tid >> 6;
  float* tile = (float*)smem;
  const int T_IN = 32 * 56, T_OUT = 32 * 32, T_PQ = 32 * 32;
  for (int t = bid; t < T_IN + T_OUT + T_PQ; t += nb) {
    const float* W; bf16_t* Wt; int N; int tt = t;
    int gsel;
    if (tt < T_IN) { W = p.w_in; Wt = p.w_in_t; N = INW; gsel = 0; }
    else if (tt < T_IN + T_OUT) { tt -= T_IN; W = p.w_out; Wt = p.w_out_t; N = DM; gsel = 1; }
    else { tt -= T_IN + T_OUT; W = p.w_pq; Wt = p.w_pq_t; N = DM; gsel = 2; }
    const int ntn = N / 64;
    const int kt = tt / ntn, nt = tt % ntn;
    {
      const int krow = tid >> 4, nq = tid & 15;
      float4 v[4];
#pragma unroll
      for (int i = 0; i < 4; i++) v[i] = *(const float4*)(W + (size_t)(kt * 64 + krow + 16 * i) * N + nt * 64 + nq * 4);
#pragma unroll
      for (int i = 0; i < 4; i++) {
        const int kk = kt * 64 + krow + 16 * i;
        const float gk = (gsel == 0) ? 1.0f : (gsel == 2) ? p.g_ffn[kk] : (kk < 1024 ? p.g_ao[kk] : p.g_lo[kk - 1024]);
        float* tp = tile + (krow + 16 * i) * 65 + nq * 4;
        tp[0] = v[i].x * gk; tp[1] = v[i].y * gk; tp[2] = v[i].z * gk; tp[3] = v[i].w * gk;
      }
    }
    __syncthreads();
    {
      const int n = tid >> 2, kq = tid & 3;
      u32x4 o0, o1;
#pragma unroll
      for (int e = 0; e < 4; e++) {
        o0[e] = pack2bf(tile[(kq * 16 + 2 * e) * 65 + n], tile[(kq * 16 + 2 * e + 1) * 65 + n]);
        o1[e] = pack2bf(tile[(kq * 16 + 8 + 2 * e) * 65 + n], tile[(kq * 16 + 8 + 2 * e + 1) * 65 + n]);
      }
      bf16_t* wp = Wt + (size_t)(nt * 64 + n) * DM + kt * 64 + kq * 16;
      *(u32x4*)(wp) = o0;
      *(u32x4*)(wp + 8) = o1;
    }
    __syncthreads();
  }
  {
    for (int i = bid * 256 + tid; i < 262144 / 8; i += nb * 256) {
      float4 a = *(const float4*)(p.sub_keys + (size_t)i * 8);
      float4 b = *(const float4*)(p.sub_keys + (size_t)i * 8 + 4);
      uint4 o;
      o.x = pack2bf(a.x, a.y); o.y = pack2bf(a.z, a.w); o.z = pack2bf(b.x, b.y); o.w = pack2bf(b.z, b.w);
      *(uint4*)(p.sk_bf + (size_t)i * 8) = o;
    }
  }
  for (int i = bid * 256 + tid; i < 3 * NTOK; i += nb * 256) p.ssq[i] = 0.f;
  for (int i = bid * 256 + tid; i < 131072; i += nb * 256) {
    const int d = i & 63, e = (i >> 6) & 63, n = (i >> 12) & 15, g = i >> 16;
    const float* W = g ? p.w_x : p.w_a;
    p.wg_t[i] = f2bf(W[(size_t)(n * 64 + d) * 64 + e]);
  }
  for (int tok = bid * 4 + wave; tok < NTOK; tok += nb * 4)
    rms_row_to_bf16(xrow(p, tok), p.g_mix, p.act + (size_t)tok * DM, lane);
}

#define GEMM_GLOAD(S, koff)                                          \
  S##a0 = *(const u32x4*)(ga + (koff));                              \
  S##a1 = *(const u32x4*)(ga + (koff) + (size_t)32 * DM);            \
  S##a2 = *(const u32x4*)(ga + (koff) + (size_t)64 * DM);            \
  if (MI == 4) S##a3 = *(const u32x4*)(ga + (koff) + (size_t)96 * DM); \
  S##b0 = *(const u32x4*)(gb + (koff));                              \
  S##b1 = *(const u32x4*)(gb + (koff) + (size_t)32 * DM);            \
  S##b2 = *(const u32x4*)(gb + (koff) + (size_t)64 * DM);            \
  S##b3 = *(const u32x4*)(gb + (koff) + (size_t)96 * DM);
#define GEMM_LSTORE(S, boff)                                         \
  *(u32x4*)(sA + (boff) + loff) = S##a0;                             \
  *(u32x4*)(sA + (boff) + loff + 32 * 64) = S##a1;                   \
  *(u32x4*)(sA + (boff) + loff + 64 * 64) = S##a2;                   \
  if (MI == 4) *(u32x4*)(sA + (boff) + loff + 96 * 64) = S##a3;      \
  *(u32x4*)(sB + (boff) + loff) = S##b0;                             \
  *(u32x4*)(sB + (boff) + loff + 32 * 64) = S##b1;                   \
  *(u32x4*)(sB + (boff) + loff + 64 * 64) = S##b2;                   \
  *(u32x4*)(sB + (boff) + loff + 96 * 64) = S##b3;
#define GEMM_COMPUTE(cA, cB)                                                                      \
  _Pragma("unroll") for (int ks = 0; ks < 2; ks++) {                                               \
    bf16x8 af[MI], bfr[4];                                                                         \
    const int kc = ks * 4 + (lane >> 4);                                                           \
    _Pragma("unroll") for (int mi = 0; mi < MI; mi++) {                                            \
      const int row = wm * (MI * 16) + mi * 16 + (lane & 15);                                      \
      af[mi] = *(const bf16x8*)((cA) + row * 64 + ((kc ^ (row & 7)) * 8));                         \
    }                                                                                              \
    _Pragma("unroll") for (int ni = 0; ni < 4; ni++) {                                             \
      const int row = wn * 64 + ni * 16 + (lane & 15);                                             \
      bfr[ni] = *(const bf16x8*)((cB) + row * 64 + ((kc ^ (row & 7)) * 8));                        \
    }                                                                                              \
    _Pragma("unroll") for (int mi = 0; mi < MI; mi++)                                              \
      _Pragma("unroll") for (int ni = 0; ni < 4; ni++)                                             \
        acc[mi][ni] = __builtin_amdgcn_mfma_f32_16x16x32_bf16(af[mi], bfr[ni], acc[mi][ni], 0, 0, 0); \
    __builtin_amdgcn_iglp_opt(0);                                                                  \
  }
template <int MODE, int MI>
__device__ void gemm_phase(const Params& p, char* smem, int bid, int nb, const bf16_t* __restrict__ A,
                           const bf16_t* __restrict__ Bt, const int N) {
  constexpr int K = DM;
  bf16_t* sA = (bf16_t*)smem;
  bf16_t* sB = sA + 2 * 8192;
  const int tid = opaque_tid(), lane = tid & 63, wave = tid >> 6;
  const int wm = wave >> 1, wn = wave & 1;
  const int ntn = N / 128;
  constexpr int BM = MI * 32;
  const int ntiles = (NTOK / BM) * ntn;
  const int lrow = tid >> 3, lkc = tid & 7;
  const u32x4 z4_ = u32x4{0, 0, 0, 0};
  u32x4 p0a0 = z4_, p0a1 = z4_, p0a2 = z4_, p0a3 = z4_, p0b0 = z4_, p0b1 = z4_, p0b2 = z4_, p0b3 = z4_;
  u32x4 p1a0 = z4_, p1a1 = z4_, p1a2 = z4_, p1a3 = z4_, p1b0 = z4_, p1b1 = z4_, p1b2 = z4_, p1b3 = z4_;
  const int loff = lrow * 64 + ((lkc ^ (lrow & 7)) * 8);
  constexpr int KT = K / 64;
  const bf16_t* ga = A;
  const bf16_t* gb = Bt;
  if (bid < ntiles) {
    ga = A + (size_t)((bid / ntn) * BM + lrow) * K + lkc * 8;
    gb = Bt + (size_t)((bid % ntn) * 128 + lrow) * K + lkc * 8;
    GEMM_GLOAD(p0, 0)
    GEMM_GLOAD(p1, 64)
  }
  for (int t = bid; t < ntiles; t += nb) {
    const int mt = t / ntn, nt = t % ntn;
    const int m0 = mt * BM, n0 = nt * 128;
    f32x4 acc[MI][4];
#pragma unroll
    for (int i = 0; i < MI; i++)
#pragma unroll
      for (int j = 0; j < 4; j++) acc[i][j] = f32x4{0.f, 0.f, 0.f, 0.f};
    GEMM_LSTORE(p0, 0)
    __syncthreads();
#pragma unroll 2
    for (int kt = 0; kt < KT; kt += 2) {
      if (MODE == 1 && kt == KT / 2) {
#pragma unroll
        for (int mi = 0; mi < MI; mi++)
#pragma unroll
          for (int j = 0; j < 4; j++) {
            const int row = m0 + wm * (MI * 16) + mi * 16 + (lane >> 4) * 4 + j;
            const float ra = rsqrtf(p.ssq[row] * (1.0f / 1024.0f) + EPSV);
            const float rl = rsqrtf(p.ssq[NTOK + row] * (1.0f / 1024.0f) + EPSV);
            const float ratio = ra / rl;
#pragma unroll
            for (int ni = 0; ni < 4; ni++) acc[mi][ni][j] *= ratio;
          }
      }
      { const int k2 = min(kt + 2, KT - 1) * 64; GEMM_GLOAD(p0, k2) }
      GEMM_COMPUTE(sA, sB)
      GEMM_LSTORE(p1, 8192)
      __syncthreads();
      { const int k3 = min(kt + 3, KT - 1) * 64; GEMM_GLOAD(p1, k3) }
      GEMM_COMPUTE(sA + 8192, sB + 8192)
      GEMM_LSTORE(p0, 0)
      __syncthreads();
    }
    {
      const int tn = t + nb;
      if (tn < ntiles) {
        ga = A + (size_t)((tn / ntn) * BM + lrow) * K + lkc * 8;
        gb = Bt + (size_t)((tn % ntn) * 128 + lrow) * K + lkc * 8;
        GEMM_GLOAD(p0, 0)
        GEMM_GLOAD(p1, 64)
      }
    }
#pragma unroll
    for (int mi = 0; mi < MI; mi++)
#pragma unroll
      for (int j = 0; j < 4; j++) {
        const int row = m0 + wm * (MI * 16) + mi * 16 + (lane >> 4) * 4 + j;
        float rs = 1.0f, sq = 0.f;
        if (MODE == 1) rs = rsqrtf(p.ssq[NTOK + row] * (1.0f / 1024.0f) + EPSV);
        if (MODE == 2) rs = rsqrtf(p.ssq[2 * NTOK + row] * (1.0f / 2048.0f) + EPSV);
#pragma unroll
        for (int ni = 0; ni < 4; ni++) {
          const int col = n0 + wn * 64 + ni * 16 + (lane & 15);
          const float v = acc[mi][ni][j] * rs;
          if (MODE == 0) p.zb[(size_t)row * INW + col] = f2bf(v);
          else if (MODE == 1) {
            const float x1 = xrow(p, row)[col] + v;
            p.out[OFF_Y + (size_t)row * DM + col] = x1;
            p.act2[(size_t)row * DM + col] = f2bf(x1);
            sq += x1 * x1;
          } else p.pq[(size_t)row * DM + col] = f2bf(v);
        }
        if (MODE == 1) {
          sq = row16_sum(sq);
          if ((lane & 15) == 0) atomicAdd(&p.ssq[2 * NTOK + row], sq);
        }
      }
  }
  if (false && MODE != 0) {
    const int rem = ntiles % nb;
    if (rem == 0 || bid >= rem) {
      const int worker = rem ? bid - rem : bid, nworkers = rem ? nb - rem : nb;
      if (MODE == 1) convert_table_fp8(p.peer_u, p.u8, 256.0f, worker, nworkers, p.g_ffn);
      else convert_table_fp8(p.peer_v, p.v8, 16.0f, worker, nworkers, nullptr);
    }
  }
}

__device__ void phase_qkprep(const Params& p, int bid, int nb) {
  const int tid = opaque_tid(), lane = tid & 63, wave = tid >> 6;
  const float gq = p.g_q[lane], gk = p.g_k[lane];
  const float inv = expf(-9.210340371976184f * (float)(lane & 31) * (2.0f / 64.0f));
  for (int tok = bid * 4 + wave; tok < NTOK; tok += nb * 4) {
    const bool prompt = tok < NPROMPT;
    const int b = prompt ? (tok >> 12) : ((tok - NPROMPT) >> 3);
    const int t = prompt ? (tok & 4095) : ((tok - NPROMPT) & 7);
    const float pos = prompt ? (float)t : (float)(8192 + t);
    float sn, cs;
    sincosf(pos * inv, &sn, &cs);
    const bf16_t* zr = p.zb + (size_t)tok * INW;
    float v[20], vv[4], ss[20];
#pragma unroll
    for (int h = 0; h < 20; h++) v[h] = bf2f_(zr[h * 64 + lane]);
#pragma unroll
    for (int kh = 0; kh < 4; kh++) vv[kh] = bf2f_(zr[1280 + kh * 64 + lane]);
#pragma unroll
    for (int h = 0; h < 20; h++) ss[h] = v[h] * v[h];
#pragma unroll
    for (int o = 32; o > 0; o >>= 1)
#pragma unroll
      for (int h = 0; h < 20; h++) ss[h] += __shfl_xor(ss[h], o);
#pragma unroll
    for (int h = 0; h < 20; h++) {
      const float y = v[h] * rsqrtf(ss[h] * (1.0f / 64.0f) + EPSV) * (h < 16 ? gq : gk);
      const float o = __shfl_xor(y, 32);
      const float r = (lane < 32) ? (y * cs - o * sn) : (y * cs + o * sn);
      if (h < 16) {
        p.qb[(size_t)tok * 1024 + h * 64 + lane] = f2bf(r);
      } else {
        const int kh = h - 16;
        p.kb[(size_t)tok * 256 + kh * 64 + lane] = f2bf(r);
        p.vb[(size_t)tok * 256 + kh * 64 + lane] = f2bf(vv[kh]);
        if (prompt) {
          if (t >= 4096 - 128) {
            const size_t o2 = ((size_t)b * 128 + (t - 3968)) * 256 + kh * 64 + lane;
            p.out[OFF_KP + o2] = r;
            p.out[OFF_VP + o2] = vv[kh];
          }
        } else {
          const size_t o2 = ((size_t)b * 128 + 120 + t) * 256 + kh * 64 + lane;
          p.out[OFF_KS + o2] = r;
          p.out[OFF_VS + o2] = vv[kh];
        }
      }
    }
  }
}

#define LRS 68
__device__ void phase_lru_local(const Params& p, char* smem, int bid, int nb) {
  const int tid = opaque_tid(), lane = tid & 63, wave = tid >> 6;
  const int r15 = lane & 15, q4 = lane >> 4;
  char* wb = smem + wave * (2048 + 2 * 16 * LRS * 4);
  bf16_t* xcb = (bf16_t*)wb;
  float* xcf = (float*)(wb + 2048);
  float* ga = xcf + 16 * LRS;
  for (int u = bid * 4 + wave; u < 4096; u += nb * 4) {
    const bool prompt = u < 2048;
    const int n = u & 15;
    const int ch = n * 64 + lane;
    int b, chunk, tok0, T;
    if (prompt) { b = u >> 10; chunk = (u >> 4) & 63; tok0 = b * 4096 + chunk * 64; T = 64; }
    else { b = (u - 2048) >> 4; chunk = 0; tok0 = NPROMPT + b * 8; T = 8; }
    bf16x8 Bf[2][4][2];
#pragma unroll
    for (int g = 0; g < 2; g++)
#pragma unroll
      for (int nt = 0; nt < 4; nt++)
#pragma unroll
        for (int ks = 0; ks < 2; ks++)
          Bf[g][nt][ks] = *(const bf16x8*)(p.wg_t + ((size_t)((g * 16 + n) * 64 + nt * 16 + r15)) * 64 + ks * 32 + q4 * 8);
    float bav[4], bxv[4], spv[4];
#pragma unroll
    for (int nt = 0; nt < 4; nt++) {
      const int e = n * 64 + nt * 16 + r15;
      bav[nt] = p.b_a[e]; bxv[nt] = p.b_x[e];
      spv[nt] = -8.0f * log1pf(expf(-p.lam[e]));
    }
    const float cb = p.conv_b[ch];
    const float cw0 = p.conv_w[ch], cw1 = p.conv_w[1024 + ch], cw2 = p.conv_w[2048 + ch], cw3 = p.conv_w[3072 + ch];
    float xm3 = 0.f, xm2 = 0.f, xm1 = 0.f, h = 0.f, P = 1.f;
    if (!prompt) {
      xm3 = p.state_conv[((size_t)b * 3 + 0) * 1024 + ch];
      xm2 = p.state_conv[((size_t)b * 3 + 1) * 1024 + ch];
      xm1 = p.state_conv[((size_t)b * 3 + 2) * 1024 + ch];
      h = p.state_h[(size_t)b * 1024 + ch];
    } else if (chunk > 0) {
      xm3 = bf2f_(p.zb[(size_t)(tok0 - 3) * INW + 1536 + ch]);
      xm2 = bf2f_(p.zb[(size_t)(tok0 - 2) * INW + 1536 + ch]);
      xm1 = bf2f_(p.zb[(size_t)(tok0 - 1) * INW + 1536 + ch]);
    }
#pragma unroll 1
    for (int t0 = 0; t0 < T; t0 += 16) {
      const int nv = min(16, T - t0);
      float xr[16];
#pragma unroll
      for (int i = 0; i < 16; i++) xr[i] = (i < nv) ? bf2f_(p.zb[(size_t)(tok0 + t0 + i) * INW + 1536 + ch]) : 0.f;
#pragma unroll
      for (int i = 0; i < 16; i++) {
        const float xc = cw0 * xm3 + cw1 * xm2 + cw2 * xm1 + cw3 * xr[i] + cb;
        if (i < nv) { xm3 = xm2; xm2 = xm1; xm1 = xr[i]; }
        xcf[i * LRS + lane] = xc;
        xcb[i * 64 + (((lane >> 3) ^ (i & 7)) * 8) + (lane & 7)] = f2bf(xc);
      }
      __builtin_amdgcn_fence(__ATOMIC_RELEASE, "wavefront");
      __builtin_amdgcn_wave_barrier();
      __builtin_amdgcn_fence(__ATOMIC_ACQUIRE, "wavefront");
      const bf16x8 A0 = *(const bf16x8*)(xcb + r15 * 64 + ((q4 ^ (r15 & 7)) * 8));
      const bf16x8 A1 = *(const bf16x8*)(xcb + r15 * 64 + (((4 + q4) ^ (r15 & 7)) * 8));
#pragma unroll
      for (int nt = 0; nt < 4; nt++) {
        f32x4 aa = f32x4{0.f, 0.f, 0.f, 0.f}, ax = f32x4{0.f, 0.f, 0.f, 0.f};
        aa = __builtin_amdgcn_mfma_f32_16x16x32_bf16(A0, Bf[0][nt][0], aa, 0, 0, 0);
        aa = __builtin_amdgcn_mfma_f32_16x16x32_bf16(A1, Bf[0][nt][1], aa, 0, 0, 0);
        ax = __builtin_amdgcn_mfma_f32_16x16x32_bf16(A0, Bf[1][nt][0], ax, 0, 0, 0);
        ax = __builtin_amdgcn_mfma_f32_16x16x32_bf16(A1, Bf[1][nt][1], ax, 0, 0, 0);
#pragma unroll
        for (int j = 0; j < 4; j++) {
          const int o = (q4 * 4 + j) * LRS + nt * 16 + r15;
          const float r = sigmoidf_(aa[j] + bav[nt]);
          const float ig = sigmoidf_(ax[j] + bxv[nt]);
          const float la = r * spv[nt];
          const float a = __expf(la);
          const float x2 = 2.0f * la;
          const float om = (x2 > -0.02f) ? (-x2 * (1.0f + x2 * (0.5f + x2 * (1.0f / 6.0f)))) : (1.0f - a * a);
          const float uu = sqrtf(om) * ig * xcf[o];
          ga[o] = a;
          xcf[o] = uu;
        }
      }
      __builtin_amdgcn_fence(__ATOMIC_RELEASE, "wavefront");
      __builtin_amdgcn_wave_barrier();
      __builtin_amdgcn_fence(__ATOMIC_ACQUIRE, "wavefront");
#pragma unroll
      for (int i = 0; i < 16; i++) {
        if (i < nv) {
          const float a = ga[i * LRS + lane];
          const float uu = xcf[i * LRS + lane];
          h = a * h + uu;
          P *= a;
          const size_t o = (size_t)(tok0 + t0 + i) * 1024 + ch;
          ((bf16_t*)p.hloc)[o] = f2bf(h);
          ((bf16_t*)p.pc)[o] = f2bf(P);
        }
      }
      __builtin_amdgcn_fence(__ATOMIC_RELEASE, "wavefront");
      __builtin_amdgcn_wave_barrier();
    }
    if (prompt) {
      p.chA[((size_t)b * 64 + chunk) * 1024 + ch] = P;
      p.chU[((size_t)b * 64 + chunk) * 1024 + ch] = h;
    }
  }
}

#define VS 200
template <int NT>
__device__ __forceinline__ void attn_qtile(const bf16_t* sK, const bf16_t* sVt, const bf16_t* qptr, const int i_idx,
                                           const int jmin, const float sink, f32x4 (&o)[4], const int lane) {
  const int r15 = lane & 15, q4 = lane >> 4;
  bf16x8 qf[2];
  qf[0] = *(const bf16x8*)(qptr);
  qf[1] = *(const bf16x8*)(qptr + 32);
  const bf16_t* kb0 = sK + r15 * 64 + ((q4 ^ (r15 & 7)) * 8);
  const bf16_t* kb1 = sK + r15 * 64 + (((4 + q4) ^ (r15 & 7)) * 8);
  f32x4 s[NT];
#pragma unroll
  for (int t = 0; t < NT; t++) {
    s[t] = f32x4{0.f, 0.f, 0.f, 0.f};
    bf16x8 a0 = *(const bf16x8*)(kb0 + t * 1024);
    bf16x8 a1 = *(const bf16x8*)(kb1 + t * 1024);
    s[t] = __builtin_amdgcn_mfma_f32_16x16x32_bf16(a0, qf[0], s[t], 0, 0, 0);
    s[t] = __builtin_amdgcn_mfma_f32_16x16x32_bf16(a1, qf[1], s[t], 0, 0, 0);
    if (t & 1) __builtin_amdgcn_sched_barrier(0);
  }
  float m = sink;
  const int jb = q4 * 4 - i_idx;
#pragma unroll
  for (int t = 0; t < NT; t++)
#pragma unroll
    for (int j = 0; j < 4; j++) {
      const int dj = t * 16 + j + jb;
      const bool valid = (dj > 0) && (dj <= 128) && (dj + i_idx >= jmin);
      float v = valid ? s[t][j] * 0.125f : -1e30f;
      s[t][j] = v;
      m = fmaxf(m, v);
    }
  m = fmaxf(m, __shfl_xor(m, 16));
  m = fmaxf(m, __shfl_xor(m, 32));
  float sum = 0.f;
#pragma unroll
  for (int t = 0; t < NT; t++)
#pragma unroll
    for (int j = 0; j < 4; j++) {
      float e = __expf(s[t][j] - m);
      s[t][j] = e;
      sum += e;
    }
  sum += __shfl_xor(sum, 16);
  sum += __shfl_xor(sum, 32);
  sum += __expf(sink - m);
  const float inv = 1.0f / sum;
  const bf16_t* vbase = sVt + r15 * VS + q4 * 4;
#pragma unroll
  for (int kk = 0; kk < NT / 2; kk++) {
    union { bf16x8 v; unsigned u[4]; } pa;
    pa.u[0] = pack2bf(s[2 * kk][0] * inv, s[2 * kk][1] * inv);
    pa.u[1] = pack2bf(s[2 * kk][2] * inv, s[2 * kk][3] * inv);
    pa.u[2] = pack2bf(s[2 * kk + 1][0] * inv, s[2 * kk + 1][1] * inv);
    pa.u[3] = pack2bf(s[2 * kk + 1][2] * inv, s[2 * kk + 1][3] * inv);
#pragma unroll
    for (int dt = 0; dt < 4; dt++) {
      union { bf16x8 v; uint2 h[2]; } bv;
      bv.h[0] = *(const uint2*)(vbase + dt * 16 * VS + kk * 32);
      bv.h[1] = *(const uint2*)(vbase + dt * 16 * VS + kk * 32 + 16);
      o[dt] = __builtin_amdgcn_mfma_f32_16x16x32_bf16(pa.v, bv.v, o[dt], 0, 0, 0);
    }
    __builtin_amdgcn_sched_barrier(0);
  }
}

__device__ __forceinline__ void kv_to_lds(bf16_t* sK, bf16_t* sVt, int key, int dc, const uint4& kv, const uint4& vv) {
  *(uint4*)(sK + key * 64 + ((dc ^ (key & 7)) * 8)) = kv;
  bf16_t* vp = sVt + (dc * 8) * VS + key;
  vp[0 * VS] = (bf16_t)(vv.x & 0xFFFF); vp[1 * VS] = (bf16_t)(vv.x >> 16);
  vp[2 * VS] = (bf16_t)(vv.y & 0xFFFF); vp[3 * VS] = (bf16_t)(vv.y >> 16);
  vp[4 * VS] = (bf16_t)(vv.z & 0xFFFF); vp[5 * VS] = (bf16_t)(vv.z >> 16);
  vp[6 * VS] = (bf16_t)(vv.w & 0xFFFF); vp[7 * VS] = (bf16_t)(vv.w >> 16);
}

__device__ void phase_attn(const Params& p, char* smem, int bid, int nb) {
  const int tid = opaque_tid(), lane = tid & 63, wave = tid >> 6;
  bf16_t* sK = (bf16_t*)smem;
  bf16_t* sVt = sK + 192 * 64;
  for (int unit = bid; unit < 512 + 512; unit += nb) {
    __syncthreads();
    if (unit < 512) {
      const int kvh = unit & 3, n = (unit >> 2) & 63, b = unit >> 8;
      if (tid < 192) {
#pragma unroll 2
        for (int i = 0; i < 8; i++) {
          const int key = tid, dc = i;
          const int tk = n * 64 - 128 + key;
          uint4 kv = uint4{0, 0, 0, 0}, vv = uint4{0, 0, 0, 0};
          if (tk >= 0) {
            kv = *(const uint4*)(p.kb + (size_t)(b * 4096 + tk) * 256 + kvh * 64 + dc * 8);
            vv = *(const uint4*)(p.vb + (size_t)(b * 4096 + tk) * 256 + kvh * 64 + dc * 8);
          }
          kv_to_lds(sK, sVt, key, dc, kv, vv);
        }
      }
      __syncthreads();
      const int hq = kvh * 4 + wave;
      const float sink = p.sinks[hq];
      const int jmin = 128 - n * 64;
#pragma unroll 1
      for (int qt = 0; qt < 4; qt++) {
        const int i_idx = qt * 16 + (lane & 15);
        const int tokq = b * 4096 + n * 64 + i_idx;
        f32x4 o[4];
#pragma unroll
        for (int dt = 0; dt < 4; dt++) o[dt] = f32x4{0.f, 0.f, 0.f, 0.f};
        attn_qtile<12>(sK, sVt, p.qb + (size_t)tokq * 1024 + hq * 64 + (lane >> 4) * 8, i_idx, jmin, sink, o, lane);
        const int tokbase = b * 4096 + n * 64 + qt * 16;
        bf16_t* op = p.act + (size_t)(tokbase + (lane >> 4) * 4) * DM + hq * 64 + (lane & 15);
#pragma unroll
        for (int j = 0; j < 4; j++) {
          float sq = 0.f;
#pragma unroll
          for (int dt = 0; dt < 4; dt++) { op[(size_t)j * DM + dt * 16] = f2bf(o[dt][j]); sq += o[dt][j] * o[dt][j]; }
          sq = row16_sum(sq);
          if ((lane & 15) == 0) atomicAdd(&p.ssq[tokbase + (lane >> 4) * 4 + j], sq);
        }
      }
    } else {
      const int us = unit - 512;
      const int kvh = us & 3, b = us >> 2;
#pragma unroll 1
      for (int i = 0; i < 5; i++) {
        const int id = tid + i * 256;
        const int key = id % 160, dc = id / 160;
        uint4 kv = uint4{0, 0, 0, 0}, vv = uint4{0, 0, 0, 0};
        if (key < 128) {
          const float* ck = p.cache_k + (((size_t)b * 128 + key) * 4 + kvh) * 64 + dc * 8;
          const float* cv = p.cache_v + (((size_t)b * 128 + key) * 4 + kvh) * 64 + dc * 8;
          float4 a0 = *(const float4*)ck, a1 = *(const float4*)(ck + 4);
          float4 b0 = *(const float4*)cv, b1 = *(const float4*)(cv + 4);
          kv.x = pack2bf(a0.x, a0.y); kv.y = pack2bf(a0.z, a0.w); kv.z = pack2bf(a1.x, a1.y); kv.w = pack2bf(a1.z, a1.w);
          vv.x = pack2bf(b0.x, b0.y); vv.y = pack2bf(b0.z, b0.w); vv.z = pack2bf(b1.x, b1.y); vv.w = pack2bf(b1.z, b1.w);
        } else if (key < 136) {
          kv = *(const uint4*)(p.kb + (size_t)(NPROMPT + b * 8 + key - 128) * 256 + kvh * 64 + dc * 8);
          vv = *(const uint4*)(p.vb + (size_t)(NPROMPT + b * 8 + key - 128) * 256 + kvh * 64 + dc * 8);
        }
        kv_to_lds(sK, sVt, key, dc, kv, vv);
      }
      __syncthreads();
      if (wave < 2) {
        const int r = lane & 15;
        const int hq = kvh * 4 + wave * 2 + (r >> 3);
        const int s_idx = r & 7;
        const int tokq = NPROMPT + b * 8 + s_idx;
        f32x4 o[4];
#pragma unroll
        for (int dt = 0; dt < 4; dt++) o[dt] = f32x4{0.f, 0.f, 0.f, 0.f};
        attn_qtile<10>(sK, sVt, p.qb + (size_t)tokq * 1024 + hq * 64 + (lane >> 4) * 8, s_idx, 0, p.sinks[hq], o, lane);
#pragma unroll
        for (int j = 0; j < 4; j++) {
          const int rr = (lane >> 4) * 4 + j;
          const int hq2 = kvh * 4 + wave * 2 + (rr >> 3);
          bf16_t* op = p.act + (size_t)(NPROMPT + b * 8 + (rr & 7)) * DM + hq2 * 64 + (lane & 15);
          float sq = 0.f;
#pragma unroll
          for (int dt = 0; dt < 4; dt++) { op[dt * 16] = f2bf(o[dt][j]); sq += o[dt][j] * o[dt][j]; }
          sq = row16_sum(sq);
          if ((lane & 15) == 0) atomicAdd(&p.ssq[NPROMPT + b * 8 + (rr & 7)], sq);
        }
      }
    }
  }
}

__device__ void phase_lru_apply(const Params& p, int bid, int nb) {
  const int tid = opaque_tid(), lane = tid & 63, wave = tid >> 6;
  for (int u = bid * 4 + wave; u < 4096; u += nb * 4) {
    const bool prompt = u < 2048;
    const int n = u & 15;
    const int ch = n * 64 + lane;
    int b, chunk, tok0, T;
    if (prompt) { b = u >> 10; chunk = (u >> 4) & 63; tok0 = b * 4096 + chunk * 64; T = 64; }
    else { b = (u - 2048) >> 4; chunk = 0; tok0 = NPROMPT + b * 8; T = 8; }
    float hin = 0.f;
    if (prompt) {
#pragma unroll 1
      for (int k0 = 0; k0 < chunk; k0 += 16) {
        float av[16], uv[16];
#pragma unroll
        for (int k = 0; k < 16; k++) {
          const bool ok = (k0 + k) < chunk;
          const size_t o = ((size_t)b * 64 + (ok ? k0 + k : 0)) * 1024 + ch;
          av[k] = p.chA[o]; uv[k] = p.chU[o];
          if (!ok) { av[k] = 1.f; uv[k] = 0.f; }
        }
#pragma unroll
        for (int k = 0; k < 16; k++) hin = av[k] * hin + uv[k];
      }
    }
    float h = 0.f;
#pragma unroll 8
    for (int t = 0; t < T; t++) {
      const size_t tok = tok0 + t;
      h = bf2f_(((const bf16_t*)p.hloc)[tok * 1024 + ch]) + bf2f_(((const bf16_t*)p.pc)[tok * 1024 + ch]) * hin;
      float yg = bf2f_(p.zb[tok * INW + 2560 + ch]);
      const float yv = h * gelu_tanh(yg);
      p.act[tok * DM + 1024 + ch] = f2bf(yv);
      const float sq = wave_sum(yv * yv);
      if (lane == 0) atomicAdd(&p.ssq[NTOK + tok], sq);
    }
    if (prompt) {
      if (chunk == 63) {
        p.out[OFF_HP + (size_t)b * 1024 + ch] = h;
#pragma unroll
        for (int j = 0; j < 3; j++)
          p.out[OFF_CP + ((size_t)b * 3 + j) * 1024 + ch] = bf2f_(p.zb[(size_t)(b * 4096 + 4093 + j) * INW + 1536 + ch]);
      }
    } else {
      p.out[OFF_HS + (size_t)b * 1024 + ch] = h;
#pragma unroll
      for (int j = 0; j < 3; j++)
        p.out[OFF_CS + ((size_t)b * 3 + j) * 1024 + ch] = bf2f_(p.zb[(size_t)(NPROMPT + b * 8 + 5 + j) * INW + 1536 + ch]);
    }
  }
}

__device__ __forceinline__ int ordf(float f) { int b = __float_as_int(f); return b ^ ((b >> 31) & 0x7FFFFFFF); }
__device__ __forceinline__ float unordf(int o) { return __int_as_float(o ^ ((o >> 31) & 0x7FFFFFFF)); }
template <int CTRL>
__device__ __forceinline__ int dppi(int v) { return __builtin_amdgcn_update_dpp(v, v, CTRL, 0xF, 0xF, false); }
__device__ __forceinline__ int row16_allmax(int m) {
  m = max(m, dppi<0xB1>(m));
  m = max(m, dppi<0x4E>(m));
  m = max(m, dppi<0x141>(m));
  m = max(m, dppi<0x140>(m));
  return m;
}
__device__ __forceinline__ int quad_allmax(int m) {
  m = max(m, dppi<0xB1>(m));
  m = max(m, dppi<0x4E>(m));
  return m;
}

__device__ void phase_peer_select(const Params& p, char* smem, int bid, int nb) {
  const int tid = opaque_tid(), lane = tid & 63, wave = tid >> 6;
  int* tab = (int*)smem;
  int* st = tab + 64 + wave * 512;
  if (tid < 64) {
    int e = -1, cnt = 0;
    for (int i = 0; i < 16; i++) {
      int nn = 16 / (i + 1);
      if (tid >= cnt && tid < cnt + nn) e = i | ((tid - cnt) << 4);
      cnt += nn;
    }
    tab[tid] = e;
  }
  __syncthreads();
  const int r15 = lane & 15, q4 = lane >> 4;
  for (int unit = bid * 4 + wave; unit < 576 * 8; unit += nb * 4) {
    const int tt = unit >> 3, hh = unit & 7;
#pragma unroll 1
    for (int c = 0; c < 2; c++) {
      f32x4 acc[8];
#pragma unroll
      for (int kt = 0; kt < 8; kt++) acc[kt] = f32x4{0.f, 0.f, 0.f, 0.f};
      const bf16_t* arow = p.pq + (size_t)(tt * 16 + r15) * DM + hh * 256 + c * 128 + q4 * 8;
      const bf16_t* brow = p.sk_bf + ((size_t)((hh * 2 + c) * 128 + r15)) * 128 + q4 * 8;
      bf16x8 af4[4];
#pragma unroll
      for (int ks = 0; ks < 4; ks++) af4[ks] = *(const bf16x8*)(arow + ks * 32);
      bf16x8 bq0[8], bq1[8];
#pragma unroll
      for (int kt = 0; kt < 8; kt++) bq0[kt] = *(const bf16x8*)(brow + kt * 16 * 128);
#pragma unroll
      for (int kt = 0; kt < 8; kt++) bq1[kt] = *(const bf16x8*)(brow + kt * 16 * 128 + 32);
      __builtin_amdgcn_sched_barrier(0);
#pragma unroll
      for (int kt = 0; kt < 8; kt++) acc[kt] = __builtin_amdgcn_mfma_f32_16x16x32_bf16(af4[0], bq0[kt], acc[kt], 0, 0, 0);
#pragma unroll
      for (int kt = 0; kt < 8; kt++) bq0[kt] = *(const bf16x8*)(brow + kt * 16 * 128 + 64);
      __builtin_amdgcn_sched_barrier(0);
#pragma unroll
      for (int kt = 0; kt < 8; kt++) acc[kt] = __builtin_amdgcn_mfma_f32_16x16x32_bf16(af4[1], bq1[kt], acc[kt], 0, 0, 0);
#pragma unroll
      for (int kt = 0; kt < 8; kt++) bq1[kt] = *(const bf16x8*)(brow + kt * 16 * 128 + 96);
      __builtin_amdgcn_sched_barrier(0);
#pragma unroll
      for (int kt = 0; kt < 8; kt++) acc[kt] = __builtin_amdgcn_mfma_f32_16x16x32_bf16(af4[2], bq0[kt], acc[kt], 0, 0, 0);
#pragma unroll
      for (int kt = 0; kt < 8; kt++) acc[kt] = __builtin_amdgcn_mfma_f32_16x16x32_bf16(af4[3], bq1[kt], acc[kt], 0, 0, 0);
      int key[8][4];
#pragma unroll
      for (int kt = 0; kt < 8; kt++)
#pragma unroll
        for (int j = 0; j < 4; j++) key[kt][j] = (ordf(acc[kt][j]) & ~127) | (127 - (kt * 16 + r15));
#define CE_(a, b) { const int hi_ = max(key[a][j], key[b][j]); const int lo_ = min(key[a][j], key[b][j]); key[a][j] = hi_; key[b][j] = lo_; }
#pragma unroll
      for (int j = 0; j < 4; j++) {
        CE_(0, 1) CE_(2, 3) CE_(4, 5) CE_(6, 7)
        CE_(0, 2) CE_(1, 3) CE_(4, 6) CE_(5, 7)
        CE_(1, 2) CE_(5, 6)
        CE_(0, 4) CE_(1, 5) CE_(2, 6) CE_(3, 7)
        CE_(2, 4) CE_(3, 5)
        CE_(1, 2) CE_(3, 4) CE_(5, 6)
      }
#undef CE_
      int top[4] = {INT32_MIN, INT32_MIN, INT32_MIN, INT32_MIN};
#pragma unroll 1
      for (int it = 0; it < 16; it++) {
#pragma unroll
        for (int j = 0; j < 4; j++) {
          const int m = row16_allmax(key[0][j]);
          const bool own = (key[0][j] == m);
#pragma unroll
          for (int kt = 0; kt < 7; kt++) key[kt][j] = own ? key[kt + 1][j] : key[kt][j];
          key[7][j] = own ? INT32_MIN : key[7][j];
          top[j] = (r15 == it) ? m : top[j];
        }
      }
#pragma unroll
      for (int j = 0; j < 4; j++) st[c * 256 + (q4 * 4 + j) * 16 + r15] = top[j];
    }
    __builtin_amdgcn_fence(__ATOMIC_RELEASE, "wavefront");
    __builtin_amdgcn_wave_barrier();
    __builtin_amdgcn_fence(__ATOMIC_ACQUIRE, "wavefront");
    const int tl = lane >> 2, sub = lane & 3;
    int ck[13];
#pragma unroll
    for (int q = 0; q < 13; q++) {
      const int pidx = sub + 4 * q;
      const int e = tab[pidx];
      int kv = INT32_MIN;
      if (e >= 0) {
        int ka = st[tl * 16 + (e & 15)];
        int kb2 = st[256 + tl * 16 + (e >> 4)];
        float s = unordf(ka & ~127) + unordf(kb2 & ~127);
        kv = (ordf(s) & ~63) | pidx;
      }
      ck[q] = kv;
    }
    int mine[4] = {0, 0, 0, 0};
    int m0 = 0;
#pragma unroll
    for (int r = 0; r < 16; r++) {
      int m = ck[0];
#pragma unroll
      for (int q = 1; q < 13; q++) m = max(m, ck[q]);
      m = quad_allmax(m);
#pragma unroll
      for (int q = 0; q < 13; q++) ck[q] = (ck[q] == m) ? INT32_MIN : ck[q];
      if (r == 0) m0 = m;
      mine[r >> 2] = (sub == (r & 3)) ? m : mine[r >> 2];
    }
    const float mx = unordf(m0 & ~63);
    float ev[4];
    float sum = 0.f;
#pragma unroll
    for (int k = 0; k < 4; k++) { ev[k] = __expf(unordf(mine[k] & ~63) - mx); sum += ev[k]; }
    sum += __shfl_xor(sum, 1);
    sum += __shfl_xor(sum, 2);
    const float inv = 1.0f / sum;
#pragma unroll
    for (int k = 0; k < 4; k++) {
      const int e = tab[mine[k] & 63];
      const int ia = 127 - (st[tl * 16 + (e & 15)] & 127);
      const int ib = 127 - (st[256 + tl * 16 + (e >> 4)] & 127);
      const size_t o = (size_t)(tt * 16 + tl) * 128 + hh * 16 + k * 4 + sub;
      p.sel_eid[o] = ia * 128 + ib;
      p.sel_g[o] = ev[k] * inv;
    }
    __builtin_amdgcn_fence(__ATOMIC_RELEASE, "wavefront");
    __builtin_amdgcn_wave_barrier();
  }
}

struct XInfo { int wx, nwx, popidx, npop; };
__device__ __forceinline__ float dppf_add8(float v) {
  v += __int_as_float(__builtin_amdgcn_update_dpp(0, __float_as_int(v), 0xB1, 0xF, 0xF, false));
  v += __int_as_float(__builtin_amdgcn_update_dpp(0, __float_as_int(v), 0x4E, 0xF, 0xF, false));
  v += __int_as_float(__builtin_amdgcn_update_dpp(0, __float_as_int(v), 0x141, 0xF, 0xF, false));
  return v;
}
__device__ __forceinline__ float dot16_fp8v(const u32x4& r, const f32x2* h2) {
  f32x2 acc = f32x2{0.f, 0.f};
#pragma unroll
  for (int q = 0; q < 4; q++) {
    f32x2 lo = __builtin_amdgcn_cvt_pk_f32_fp8((int)r[q], false);
    f32x2 hi = __builtin_amdgcn_cvt_pk_f32_fp8((int)r[q], true);
    acc = lo * h2[q * 2] + acc;
    acc = hi * h2[q * 2 + 1] + acc;
  }
  return acc[0] + acc[1];
}
__device__ __forceinline__ void axpy16_fp8v(float w, const u32x4& r, f32x2* f2) {
  const f32x2 w2 = f32x2{w, w};
#pragma unroll
  for (int q = 0; q < 4; q++) {
    f32x2 lo = __builtin_amdgcn_cvt_pk_f32_fp8((int)r[q], false);
    f32x2 hi = __builtin_amdgcn_cvt_pk_f32_fp8((int)r[q], true);
    f2[q * 2] = w2 * lo + f2[q * 2];
    f2[q * 2 + 1] = w2 * hi + f2[q * 2 + 1];
  }
}
#define NITEM (NTOK * 128)
__device__ __forceinline__ void phase_peer_u(const Params& p, const XInfo& xi) {
  const int tid = opaque_tid(), lane = tid & 63, j8 = lane & 7, g = lane >> 3;
  int nown = 0;
  for (int ss = 0; ss < 16; ss++) nown += (((ss >> 1) % xi.npop) == xi.popidx) ? 1 : 0;
  const int nitems = nown * (NTOK / 8);
#pragma unroll 1
  for (int idx = xi.wx; idx < nitems; idx += xi.nwx) {
    const int ord = idx / (NTOK / 8), B = idx % (NTOK / 8);
    int ss = 0;
    { int c = 0; for (int q = 0; q < 16; q++) if (((q >> 1) % xi.npop) == xi.popidx) { if (c == ord) ss = q; c++; } }
    const unsigned char* ub = p.u8 + ss * 128 + j8 * 16;
    bf16_t* pdst = (bf16_t*)p.pd + (size_t)ss * NITEM;
    {
      const int tok = B * 8 + g;
      const bool valid = true;
      f32x2 h2[8];
      {
        const bf16_t* hrow = p.act2 + (size_t)tok * DM + ss * 128 + j8 * 16;
        u32x4 r0 = *(const u32x4*)(hrow), r1 = *(const u32x4*)(hrow + 8);
#pragma unroll
        for (int q = 0; q < 4; q++) {
          h2[q] = f32x2{bflo(r0[q]), bfhi(r0[q])};
          h2[4 + q] = f32x2{bflo(r1[q]), bfhi(r1[q])};
        }
      }
      const int* ep = p.sel_eid + (size_t)tok * 128;
      i32x8 e;
#pragma unroll
      for (int k = 0; k < 8; k++) e[k] = ep[k];
#pragma unroll 1
      for (int it0 = 0; it0 < 128; it0 += 8) {
        u32x4 r[8];
#pragma unroll
        for (int k = 0; k < 8; k++) r[k] = *(const u32x4*)(ub + (size_t)e[k] * DM);
        const int itn = (it0 + 8) & 127;
#pragma unroll
        for (int k = 0; k < 8; k++) e[k] = ep[itn + k];
        float d[8];
#pragma unroll
        for (int k = 0; k < 8; k++) d[k] = dppf_add8(dot16_fp8v(r[k], h2));
        float o = d[0];
#pragma unroll
        for (int k = 1; k < 8; k++) o = (j8 == k) ? d[k] : o;
        if (valid) pdst[(size_t)tok * 128 + it0 + j8] = f2bf(o);
      }
    }
  }
}
__device__ void phase_peer_w(const Params& p, int bid, int nb) {
  const int tid = opaque_tid();
  for (int i = bid * 256 + tid; i < NITEM; i += nb * 256) {
    float sacc = 0.f;
#pragma unroll
    for (int ss = 0; ss < 16; ss++) sacc += bf2f_(((const bf16_t*)p.pd)[(size_t)ss * NITEM + i]);
    const float rf = rsqrtf(p.ssq[2 * NTOK + (i >> 7)] * (1.0f / 2048.0f) + EPSV);
    p.sel_g[i] = gelu_tanh(sacc * rf * (1.0f / 256.0f)) * p.sel_g[i] * (1.0f / 16.0f);
  }
}
__device__ __forceinline__ void phase_peer_v(const Params& p, const XInfo& xi) {
  const int tid = opaque_tid(), lane = tid & 63, j8 = lane & 7, g = lane >> 3;
  int nown = 0;
  for (int ss = 0; ss < 16; ss++) nown += (((ss >> 1) % xi.npop) == xi.popidx) ? 1 : 0;
  const int nitems = nown * (NTOK / 8);
#pragma unroll 1
  for (int idx = xi.wx; idx < nitems; idx += xi.nwx) {
    const int ord = idx / (NTOK / 8), B = idx % (NTOK / 8);
    int ss = 0;
    { int c = 0; for (int q = 0; q < 16; q++) if (((q >> 1) % xi.npop) == xi.popidx) { if (c == ord) ss = q; c++; } }
    const unsigned char* vb8 = p.v8 + ss * 128 + j8 * 16;
    {
      const int tok = B * 8 + g;
      const bool valid = true;
      f32x2 f2[8];
#pragma unroll
      for (int q = 0; q < 8; q++) f2[q] = f32x2{0.f, 0.f};
      const int* ep = p.sel_eid + (size_t)tok * 128;
      const float* wp = p.sel_g + (size_t)tok * 128;
      i32x8 e; f32x8 w;
#pragma unroll
      for (int k = 0; k < 8; k++) { e[k] = ep[k]; w[k] = wp[k]; }
#pragma unroll 1
      for (int it0 = 0; it0 < 128; it0 += 8) {
        u32x4 r[8]; float wc[8];
#pragma unroll
        for (int k = 0; k < 8; k++) { r[k] = *(const u32x4*)(vb8 + (size_t)e[k] * DM); wc[k] = w[k]; }
        const int itn = (it0 + 8) & 127;
#pragma unroll
        for (int k = 0; k < 8; k++) { e[k] = ep[itn + k]; w[k] = wp[itn + k]; }
#pragma unroll
        for (int k = 0; k < 8; k++) axpy16_fp8v(wc[k], r[k], f2);
      }
      if (valid) {
        float* orow = p.out + OFF_Y + (size_t)tok * DM + ss * 128 + j8 * 16;
#pragma unroll
        for (int q = 0; q < 4; q++) {
          float4 a = *(float4*)(orow + q * 4);
          a.x += f2[q * 2][0]; a.y += f2[q * 2][1]; a.z += f2[q * 2 + 1][0]; a.w += f2[q * 2 + 1][1];
          *(float4*)(orow + q * 4) = a;
        }
      }
    }
  }
}

#define XB_TMO      128
#define XB_XCNT(j)  (256  + 64 * (j))
#define XB_XSUB(j)  (1280 + 64 * (j))
#define XB_XGEN(j)  (2304 + 64 * (j))
#define XB_TOP      3328
#define XB_TOPGEN   3392
#define XCD_BAR_WORDS 3456
#define XB_SPIN_CAP (1u << 22)
#define LAS __attribute__((address_space(3)))
__device__ __forceinline__ unsigned xb_ld(unsigned* p)              { return __hip_atomic_load(p, __ATOMIC_RELAXED, __HIP_MEMORY_SCOPE_AGENT); }
__device__ __forceinline__ unsigned xb_add(unsigned* p, unsigned v) { return __hip_atomic_fetch_add(p, v, __ATOMIC_RELAXED, __HIP_MEMORY_SCOPE_AGENT); }
__device__ __forceinline__ unsigned xb_xcc_id() { return (unsigned)__builtin_amdgcn_s_getreg((3 << 11) | 20) & 0xFu; }
#define XB_SPIN(cond, bar) do { unsigned _sp = 0; while (cond) { __builtin_amdgcn_s_sleep(24); \
    if ((++_sp & 255u) == 0u) { if (xb_ld(&(bar)[XB_TMO])) break; if (_sp > XB_SPIN_CAP) { atomicAdd(&(bar)[XB_TMO], 1u); break; } } } } while (0)
struct XcdBarrier { unsigned* bar; unsigned x; unsigned nloc, nx; };
__device__ __forceinline__ XcdBarrier xcd_barrier_post(unsigned* bar) {
  XcdBarrier b; b.bar = bar; b.x = xb_xcc_id(); b.nloc = 0u; b.nx = 0u;
  if (threadIdx.x == 0) (void)xb_add(&bar[XB_XCNT(b.x)], 1u);
  return b;
}
__device__ __forceinline__ void xcd_barrier_complete(unsigned* bar, unsigned x, unsigned& nloc, unsigned& nx) {
  const unsigned G = gridDim.x * gridDim.y * gridDim.z;
  unsigned sum, cnt, mine, sp = 0u;
  for (;;) {
    sum = 0u; cnt = 0u; mine = 0u;
#pragma unroll
    for (unsigned j = 0; j < 16; ++j) { const unsigned c = xb_ld(&bar[XB_XCNT(j)]); sum += c; cnt += (c > 0u) ? 1u : 0u; mine = (j == x) ? c : mine; }
    if (sum == G) break;
    __builtin_amdgcn_s_sleep(1);
    if ((++sp & 255u) == 0u) { if (xb_ld(&bar[XB_TMO])) break; if (sp > XB_SPIN_CAP) { atomicAdd(&bar[XB_TMO], 1u); break; } }
  }
  nloc = mine > 0u ? mine : 1u; nx = cnt > 0u ? cnt : 1u;
}
__device__ __forceinline__ void xcd_barrier(XcdBarrier& b) {
  asm volatile("s_waitcnt vmcnt(0)" ::: "memory");
  __syncthreads();
  if (threadIdx.x == 0) {
    unsigned* bar = b.bar;
    __builtin_amdgcn_s_waitcnt(0);
    unsigned nloc = b.nloc, nx = b.nx;
    if (nloc == 0u) { xcd_barrier_complete(bar, b.x, nloc, nx); b.nloc = nloc; b.nx = nx; }
    const unsigned old = xb_add(&bar[XB_XSUB(b.x)], 1u);
    const unsigned gen = old / nloc;
    if (old + 1u == (gen + 1u) * nloc) {
      __builtin_amdgcn_fence(__ATOMIC_RELEASE, "agent");
      asm volatile("s_waitcnt vmcnt(0)" ::: "memory");
      const unsigned og = xb_add(&bar[XB_TOP], 1u);
      const unsigned tg = og / nx;
      if (og + 1u == (tg + 1u) * nx) xb_add(&bar[XB_TOPGEN], 1u);
      else XB_SPIN(xb_ld(&bar[XB_TOPGEN]) == tg, bar);
      __builtin_amdgcn_fence(__ATOMIC_ACQUIRE, "agent");
      xb_add(&bar[XB_XGEN(b.x)], 1u);
      asm volatile("s_waitcnt vmcnt(0)" ::: "memory");
    } else {
      XB_SPIN(xb_ld(&bar[XB_XGEN(b.x)]) == gen, bar);
      __builtin_amdgcn_fence(__ATOMIC_ACQUIRE, "agent");
      asm volatile("s_waitcnt vmcnt(0)" ::: "memory");
    }
  }
  __syncthreads();
}

#define NPHASE 10
__device__ __forceinline__ void run_phase(const Params& p, char* smem, int ph, int bid, int nb, const XInfo& xi, const int role) {
  switch (ph) {
    case 0: phase_convert(p, smem, bid, nb); break;
    case 1: gemm_phase<0, 4>(p, smem, bid, nb, p.act, p.w_in_t, INW); break;
    case 2: phase_qkprep(p, bid, nb); phase_lru_local(p, smem, bid, nb); break;
    case 3: phase_attn(p, smem, bid, nb); phase_lru_apply(p, bid, nb); break;
    case 4: gemm_phase<1, 3>(p, smem, bid, nb, p.act, p.w_out_t, DM); break;
    case 5: gemm_phase<2, 3>(p, smem, bid, nb, p.act2, p.w_pq_t, DM); break;
    case 6:
      if (role == 0) {
        convert_table_fp8(p.peer_u, p.u8, 256.0f, bid, nb, p.g_ffn);
        convert_table_fp8(p.peer_v, p.v8, 16.0f, bid, nb, nullptr);
        copy_cache_rows(p, bid, nb);
        phase_peer_select(p, smem, bid, nb);
      } else {
        phase_peer_select(p, smem, bid, nb);
        convert_table_fp8(p.peer_u, p.u8, 256.0f, bid, nb, p.g_ffn);
        convert_table_fp8(p.peer_v, p.v8, 16.0f, bid, nb, nullptr);
        copy_cache_rows(p, bid, nb);
      }
      break;
    case 7: phase_peer_u(p, xi); break;
    case 8: phase_peer_w(p, bid, nb); break;
    case 9: phase_peer_v(p, xi); break;
  }
}

#if ONE_LAUNCH
__global__ void __launch_bounds__(256, 2) k_mega(Params p) {
  __shared__ __attribute__((aligned(16))) char smem[65536];
  __shared__ int s_rank[4];
  XcdBarrier xb; xb.bar = p.bar; xb.x = xb_xcc_id(); xb.nloc = 0u; xb.nx = 0u;
  if (threadIdx.x == 0) {
    s_rank[0] = (int)xb_add(&p.bar[XB_XCNT(xb.x)], 1u);
    const unsigned hwid = (unsigned)__builtin_amdgcn_s_getreg((31 << 11) | 4);
    const unsigned slot = (hwid >> 8) & 0xFFu;
    s_rank[1] = (int)(xb_add(&p.bar[XCD_BAR_WORDS + xb.x * 256 + slot], 1u) & 1u);
  }
  __syncthreads();
  const int rank = s_rank[0];
  const int role = (blockIdx.x >= gridDim.x / 2) ? 1 : 0;
  XInfo xi{0, 0, 0, 1};
#pragma unroll 1
  for (int ph = 0; ph < NPHASE; ph++) {
    if (ph == 7) {
      int npop = 0, popidx = 0, nloc = 1;
      for (int j = 0; j < 16; j++) {
        const int c = (int)xb_ld(&p.bar[XB_XCNT(j)]);
        if (c > 0) { if (j == (int)xb.x) { popidx = npop; nloc = c; } npop++; }
      }
      xi.wx = rank * 4 + (threadIdx.x >> 6); xi.nwx = nloc * 4; xi.popidx = popidx; xi.npop = npop;
    }
    run_phase(p, smem, ph, blockIdx.x, gridDim.x, xi, role);
    if (ph + 1 < NPHASE) xcd_barrier(xb);
  }
}
#endif

extern "C" void kernel_launch(void* const* d_in, const int* in_sizes, int n_in, void* d_out, int out_size, void* d_ws,
                              size_t ws_size, hipStream_t stream) {
  Params p{};
  const float* const* in = (const float* const*)d_in;
  p.x_prompt = in[0]; p.x_sample = in[1]; p.cache_k = in[2]; p.cache_v = in[3]; p.state_conv = in[4]; p.state_h = in[5];
  p.g_mix = in[6]; p.w_in = in[7]; p.g_q = in[8]; p.g_k = in[9]; p.sinks = in[10]; p.conv_w = in[11]; p.conv_b = in[12];
  p.w_a = in[13]; p.b_a = in[14]; p.w_x = in[15]; p.b_x = in[16]; p.lam = in[17]; p.g_ao = in[18]; p.g_lo = in[19];
  p.w_out = in[20]; p.g_ffn = in[21]; p.w_pq = in[22]; p.sub_keys = in[23]; p.peer_u = in[24]; p.peer_v = in[25];
  p.out = (float*)d_out;
  char* w = (char*)d_ws;
  size_t off = 0;
  auto take = [&](size_t bytes) { char* r = w + off; off += (bytes + 255) & ~(size_t)255; return r; };
  p.w_in_t = (bf16_t*)take((size_t)INW * DM * 2);
  p.w_out_t = (bf16_t*)take((size_t)DM * DM * 2);
  p.w_pq_t = (bf16_t*)take((size_t)DM * DM * 2);
  p.sk_bf = (bf16_t*)take((size_t)262144 * 2);
  p.wg_t = (bf16_t*)take((size_t)131072 * 2);
  p.u8 = (unsigned char*)take((size_t)16384 * DM);
  p.v8 = (unsigned char*)take((size_t)16384 * DM);
  p.act = (bf16_t*)take((size_t)NTOK * DM * 2);
  p.z = (float*)take((size_t)NTOK * INW * 4);
  p.zb = (bf16_t*)p.z;
  p.qb = (bf16_t*)take((size_t)NTOK * 1024 * 2);
  p.kb = (bf16_t*)take((size_t)NTOK * 256 * 2);
  p.vb = (bf16_t*)take((size_t)NTOK * 256 * 2);
  p.hloc = (float*)take((size_t)NTOK * 1024 * 4);
  p.pc = (float*)take((size_t)NTOK * 1024 * 4);
  p.chA = (float*)take((size_t)2 * 64 * 1024 * 4);
  p.chU = (float*)take((size_t)2 * 64 * 1024 * 4);
  p.mixraw = (float*)take((size_t)NTOK * DM * 4);
  p.act2 = (bf16_t*)p.mixraw;
  p.ssq = (float*)take((size_t)3 * NTOK * 4);
  p.bar = (unsigned*)take((size_t)(XCD_BAR_WORDS + 16 * 256) * 4);
  p.pd = p.hloc;
  p.pq = (bf16_t*)p.z;
  p.sel_eid = (int*)((char*)p.z + (size_t)NTOK * DM * 2);
  p.sel_g = (float*)((char*)p.z + (size_t)NTOK * DM * 2 + (size_t)NTOK * 128 * 4);
  if (off > ws_size) { fprintf(stderr, "workspace too small: need %zu have %zu\n", off, ws_size); return; }

  static int grid_blocks = 0;
  if (!grid_blocks) {
    int dev = 0, cus = 0, per_cu = 0;
    (void)hipGetDevice(&dev);
    (void)hipDeviceGetAttribute(&cus, hipDeviceAttributeMultiprocessorCount, dev);
#if ONE_LAUNCH
    (void)hipOccupancyMaxActiveBlocksPerMultiprocessor(&per_cu, k_mega, 256, 0);
#endif
    if (per_cu > 2) per_cu = 2;
    if (per_cu < 1) per_cu = 1;
    grid_blocks = cus * per_cu;
  }
#if ONE_LAUNCH
  (void)hipMemsetAsync(p.bar, 0, (size_t)(XCD_BAR_WORDS + 16 * 256) * 4, stream);
  void* args[] = {&p};
  hipError_t e = hipLaunchCooperativeKernel((void*)k_mega, dim3(grid_blocks), dim3(256), args, 0, stream);
  if (e != hipSuccess) fprintf(stderr, "cooperative launch failed: %s (grid %d)\n", hipGetErrorString(e), grid_blocks);
#endif
}
```
